# Optimizing an MI355X kernel written in HIP

```python
import math
import jax
import jax.numpy as jnp
from jax import lax
import numpy as np

D_MODEL = 1024
BATCH = 4
SEQ = 8192
DEPTH = 2

CHUNK = 64
N_A_LAYERS = DEPTH // 2
N_B_LAYERS = DEPTH - N_A_LAYERS
DN_HEADS = 8
DN_DK = 128
DN_DV = 128
DN_QK_WIDTH = DN_HEADS * DN_DK
DN_V_WIDTH = DN_HEADS * DN_DV
CONV_WIDTH = 4
DN_IN_WIDTH = 2 * DN_QK_WIDTH + 2 * DN_V_WIDTH + 2 * DN_HEADS
ATT_HEADS = 16
ATT_DH = 64
ATT_WIDTH = ATT_HEADS * ATT_DH
LEFT_CHUNKS = 8
BAND = (LEFT_CHUNKS + 1) * CHUNK
MAX_REL = 256
REL_BIAS_SIZE = CHUNK + MAX_REL
N_EXPERTS = 256
TOP_K = 8
N_GROUPS = 8
TOPK_GROUPS = 4
D_EXPERT = 256
D_SHARED = 256
ROUTED_SCALE = 2.5
EXPERT_BLOCK = 128
DN_ALPHA = (2 * DEPTH) ** 0.25
DN_BETA = (8 * DEPTH) ** -0.25
LN_EPS = 1e-5
NORM_EPS = 1e-6

kernel_name = "yoco_deltanet_chunkattn_moe_deepnorm"


def layer_norm(x, g, b):
    xf = x.astype(jnp.float32)
    mu = jnp.mean(xf, axis=-1, keepdims=True)
    var = jnp.mean(jnp.square(xf - mu), axis=-1, keepdims=True)
    return ((xf - mu) * lax.rsqrt(var + LN_EPS) * g + b).astype(x.dtype)


def l2norm(x):
    xf = x.astype(jnp.float32)
    return xf * lax.rsqrt(jnp.sum(xf * xf, axis=-1, keepdims=True) + NORM_EPS)


def causal_short_conv(x, w):
    s = x.shape[1]
    xp = jnp.pad(x, ((0, 0), (CONV_WIDTH - 1, 0), (0, 0)))
    y = xp[:, 0:s] * w[0]
    for j in range(1, CONV_WIDTH):
        y = y + xp[:, j:j + s] * w[j]
    return jax.nn.silu(y)


def to_chunks(t):
    b, s, h = t.shape[:3]
    nc = s // CHUNK
    if t.ndim == 4:
        return t.reshape(b, nc, CHUNK, h, t.shape[3]).transpose(1, 0, 3, 2, 4)
    return t.reshape(b, nc, CHUNK, h).transpose(1, 0, 3, 2)


def chunk_gated_delta_rule(q, k, v, g, beta):
    bsz, s, h, dk = q.shape
    dv = v.shape[-1]
    q = to_chunks(q * (dk ** -0.5))
    k = to_chunks(k)
    v = to_chunks(v)
    g = to_chunks(g)
    beta = to_chunks(beta)
    gc = jnp.cumsum(g, axis=-1)
    idx = jnp.arange(CHUNK)
    incl = idx[:, None] >= idx[None, :]
    strict = idx[:, None] > idx[None, :]
    decay = jnp.exp(jnp.where(incl, gc[..., :, None] - gc[..., None, :], -jnp.inf))
    kb = k * beta[..., None]
    a_mat = jnp.where(strict, jnp.einsum('nbhid,nbhjd->nbhij', kb, k) * decay, 0.0)
    m = a_mat + jnp.eye(CHUNK, dtype=a_mat.dtype)
    rhs = jnp.concatenate([v * beta[..., None], kb * jnp.exp(gc)[..., None]], axis=-1)
    sol = lax.linalg.triangular_solve(m, rhs, left_side=True, lower=True, unit_diagonal=True)
    u = sol[..., :dv]
    w = sol[..., dv:]
    p_intra = jnp.einsum('nbhid,nbhjd->nbhij', q, k) * decay
    g_last = gc[..., -1]
    qg = q * jnp.exp(gc)[..., None]
    kd = k * jnp.exp(g_last[..., None] - gc)[..., None]

    def step(state, inp):
        qg_c, kd_c, u_c, w_c, p_c, gl_c = inp
        v_new = u_c - jnp.einsum('bhcd,bhde->bhce', w_c, state)
        o = jnp.einsum('bhcd,bhde->bhce', qg_c, state) + jnp.einsum('bhij,bhje->bhie', p_c, v_new)
        state = state * jnp.exp(gl_c)[..., None, None] + jnp.einsum('bhcd,bhce->bhde', kd_c, v_new)
        return state, o

    s0 = jnp.zeros((bsz, h, dk, dv), jnp.float32)
    _, o = lax.scan(step, s0, (qg, kd, u, w, p_intra, g_last))
    return o.transpose(1, 0, 3, 2, 4).reshape(bsz, s, h, dv)


def gated_deltanet(x, w_in, conv_w, a_log, dt_bias, out_norm_g, w_out):
    bsz, s, _ = x.shape
    proj = x @ w_in
    qkv = proj[..., :2 * DN_QK_WIDTH + DN_V_WIDTH]
    z = proj[..., 2 * DN_QK_WIDTH + DN_V_WIDTH:2 * DN_QK_WIDTH + 2 * DN_V_WIDTH]
    a = proj[..., 2 * DN_QK_WIDTH + 2 * DN_V_WIDTH:2 * DN_QK_WIDTH + 2 * DN_V_WIDTH + DN_HEADS]
    b = proj[..., 2 * DN_QK_WIDTH + 2 * DN_V_WIDTH + DN_HEADS:]
    qkv = causal_short_conv(qkv, conv_w)
    q = l2norm(qkv[..., :DN_QK_WIDTH].reshape(bsz, s, DN_HEADS, DN_DK))
    k = l2norm(qkv[..., DN_QK_WIDTH:2 * DN_QK_WIDTH].reshape(bsz, s, DN_HEADS, DN_DK))
    v = qkv[..., 2 * DN_QK_WIDTH:].reshape(bsz, s, DN_HEADS, DN_DV).astype(jnp.float32)
    beta = jax.nn.sigmoid(b.astype(jnp.float32))
    g = -jnp.exp(a_log) * jax.nn.softplus(a.astype(jnp.float32) + dt_bias)
    o = chunk_gated_delta_rule(q, k, v, g, beta)
    o = o * lax.rsqrt(jnp.mean(o * o, axis=-1, keepdims=True) + NORM_EPS) * out_norm_g
    o = o * jax.nn.silu(z.reshape(bsz, s, DN_HEADS, DN_DV).astype(jnp.float32))
    return o.astype(x.dtype).reshape(bsz, s, DN_V_WIDTH) @ w_out


def shared_kv(x, w_kv):
    bsz, s, _ = x.shape
    kv = x @ w_kv
    k = kv[..., :ATT_WIDTH].reshape(bsz, s, ATT_HEADS, ATT_DH).transpose(0, 2, 1, 3)
    v = kv[..., ATT_WIDTH:].reshape(bsz, s, ATT_HEADS, ATT_DH).transpose(0, 2, 1, 3)
    return k, v


def chunked_relpos_attention(x, w_q, rel_bias_table, k_sh, v_sh, w_out):
    bsz, s, _ = x.shape
    nc = s // CHUNK
    pad = LEFT_CHUNKS * CHUNK
    q = (x @ w_q).reshape(bsz, nc, CHUNK, ATT_HEADS, ATT_DH).transpose(1, 0, 3, 2, 4) * (ATT_DH ** -0.5)
    kp = jnp.pad(k_sh, ((0, 0), (0, 0), (pad, 0), (0, 0)))
    vp = jnp.pad(v_sh, ((0, 0), (0, 0), (pad, 0), (0, 0)))
    i_loc = jnp.arange(CHUNK)
    j_band = jnp.arange(BAND)
    rel = i_loc[:, None] + pad - j_band[None, :]
    rel_idx = jnp.clip(rel, -(CHUNK - 1), MAX_REL) + (CHUNK - 1)
    bias = rel_bias_table[:, rel_idx].astype(jnp.float32)

    def one_chunk(args):
        q_c, c = args
        start = c * CHUNK
        k_band = lax.dynamic_slice_in_dim(kp, start, BAND, axis=2)
        v_band = lax.dynamic_slice_in_dim(vp, start, BAND, axis=2)
        sc = jnp.einsum('bhqd,bhkd->bhqk', q_c, k_band).astype(jnp.float32) + bias
        valid = (start - pad + j_band) >= 0
        sc = jnp.where(valid[None, None, None, :], sc, -jnp.inf)
        p = jax.nn.softmax(sc, axis=-1).astype(v_band.dtype)
        return jnp.einsum('bhqk,bhkd->bhqd', p, v_band)

    o = lax.map(one_chunk, (q, jnp.arange(nc)))
    o = o.transpose(1, 0, 3, 2, 4).reshape(bsz, s, ATT_WIDTH)
    return o @ w_out


def swiglu(x, w_gu, w_d):
    h = x @ w_gu
    f = w_d.shape[0]
    return (jax.nn.silu(h[..., :f]) * h[..., f:]) @ w_d


def routed_experts(xf, eidx, gates, w_gate_up, w_down):
    n = xf.shape[0]
    n_assign = n * TOP_K
    p_rows = n_assign + N_EXPERTS * EXPERT_BLOCK
    n_blocks = p_rows // EXPERT_BLOCK
    flat_e = eidx.reshape(-1)
    order = jnp.argsort(flat_e)
    sorted_e = flat_e[order]
    sorted_tok = order // TOP_K
    sorted_w = gates.reshape(-1)[order]
    counts = jnp.zeros((N_EXPERTS,), jnp.int32).at[flat_e].add(1)
    padded = (counts + EXPERT_BLOCK - 1) // EXPERT_BLOCK * EXPERT_BLOCK
    start = jnp.cumsum(counts) - counts
    pend = jnp.cumsum(padded)
    pstart = pend - padded
    dest = pstart[sorted_e] + jnp.arange(n_assign) - start[sorted_e]
    buf_tok = jnp.zeros((p_rows,), jnp.int32).at[dest].set(sorted_tok.astype(jnp.int32))
    buf_w = jnp.zeros((p_rows,), gates.dtype).at[dest].set(sorted_w)
    block_e = jnp.minimum(jnp.searchsorted(pend, jnp.arange(n_blocks) * EXPERT_BLOCK, side='right'),
                          N_EXPERTS - 1)

    def step(out, inp):
        tok, wt, e = inp
        y = swiglu(xf[tok], w_gate_up[e], w_down[e])
        return out.at[tok].add(y * wt[:, None]), None

    out, _ = lax.scan(step, jnp.zeros_like(xf),
                      (buf_tok.reshape(n_blocks, EXPERT_BLOCK), buf_w.reshape(n_blocks, EXPERT_BLOCK), block_e))
    return out


def moe_ffn(x, w_router, router_bias, w_gate_up, w_down, w_shared_gu, w_shared_down):
    bsz, s, d = x.shape
    xf = x.reshape(-1, d)
    n = xf.shape[0]
    scores = jax.nn.sigmoid((xf @ w_router).astype(jnp.float32))
    sel = scores + router_bias.astype(jnp.float32)
    grp_score = jnp.sum(lax.top_k(sel.reshape(n, N_GROUPS, N_EXPERTS // N_GROUPS), 2)[0], axis=-1)
    _, top_groups = lax.top_k(grp_score, TOPK_GROUPS)
    gmask = jnp.sum(jax.nn.one_hot(top_groups, N_GROUPS, dtype=jnp.float32), axis=-2) > 0
    sel = jnp.where(jnp.repeat(gmask, N_EXPERTS // N_GROUPS, axis=-1), sel, -jnp.inf)
    _, eidx = lax.top_k(sel, TOP_K)
    wts = jnp.take_along_axis(scores, eidx, axis=-1)
    wts = wts / jnp.sum(wts, axis=-1, keepdims=True) * ROUTED_SCALE
    routed = routed_experts(xf, eidx, wts.astype(x.dtype), w_gate_up, w_down)
    shared = swiglu(xf, w_shared_gu, w_shared_down)
    return (routed + shared).reshape(bsz, s, d)


def setup_inputs(seed: int = 0) -> dict:
    key = jax.random.key(seed)
    ks = jax.random.split(key, 24)
    f32 = jnp.float32
    nrm = lambda k, shape, scale: jax.random.normal(k, shape, f32) * scale
    x = jax.random.normal(ks[0], (BATCH, SEQ, D_MODEL), f32)
    a_col_scale = jnp.ones((DN_IN_WIDTH,), f32).at[2 * DN_QK_WIDTH:2 * DN_QK_WIDTH + DN_V_WIDTH].set(DN_BETA)
    a_w_in = nrm(ks[1], (N_A_LAYERS, D_MODEL, DN_IN_WIDTH), D_MODEL ** -0.5) * a_col_scale
    a_conv_w = nrm(ks[2], (N_A_LAYERS, CONV_WIDTH, 2 * DN_QK_WIDTH + DN_V_WIDTH), CONV_WIDTH ** -0.5)
    a_a_log = jnp.log(jax.random.uniform(ks[3], (N_A_LAYERS, DN_HEADS), f32, 1.0, 16.0))
    dt = jnp.exp(jax.random.uniform(ks[4], (N_A_LAYERS, DN_HEADS), f32, math.log(1e-3), math.log(1e-1)))
    a_dt_bias = dt + jnp.log(-jnp.expm1(-dt))
    a_out_norm_g = 1.0 + nrm(ks[5], (N_A_LAYERS, DN_DV), 0.02)
    a_w_out = nrm(ks[6], (N_A_LAYERS, DN_V_WIDTH, D_MODEL), DN_V_WIDTH ** -0.5 * DN_BETA)
    kv_col_scale = jnp.ones((2 * ATT_WIDTH,), f32).at[ATT_WIDTH:].set(DN_BETA)
    w_kv_shared = nrm(ks[7], (D_MODEL, 2 * ATT_WIDTH), D_MODEL ** -0.5) * kv_col_scale
    b_w_q = nrm(ks[8], (N_B_LAYERS, D_MODEL, ATT_WIDTH), D_MODEL ** -0.5)
    b_rel_bias = nrm(ks[9], (N_B_LAYERS, ATT_HEADS, REL_BIAS_SIZE), 0.2)
    b_w_out = nrm(ks[10], (N_B_LAYERS, ATT_WIDTH, D_MODEL), ATT_WIDTH ** -0.5 * DN_BETA)
    moe_w_router = nrm(ks[11], (DEPTH, D_MODEL, N_EXPERTS), D_MODEL ** -0.5)
    moe_router_bias = nrm(ks[12], (DEPTH, N_EXPERTS), 0.01)
    moe_w_gate_up = nrm(ks[13], (DEPTH, N_EXPERTS, D_MODEL, 2 * D_EXPERT), D_MODEL ** -0.5)
    moe_w_down = nrm(ks[14], (DEPTH, N_EXPERTS, D_EXPERT, D_MODEL), D_EXPERT ** -0.5 * DN_BETA)
    moe_w_shared_gate_up = nrm(ks[15], (DEPTH, D_MODEL, 2 * D_SHARED), D_MODEL ** -0.5)
    moe_w_shared_down = nrm(ks[16], (DEPTH, D_SHARED, D_MODEL), D_SHARED ** -0.5 * DN_BETA)
    ln_mix_g = 1.0 + nrm(ks[17], (DEPTH, D_MODEL), 0.02)
    ln_mix_b = nrm(ks[18], (DEPTH, D_MODEL), 0.02)
    ln_ffn_g = 1.0 + nrm(ks[19], (DEPTH, D_MODEL), 0.02)
    ln_ffn_b = nrm(ks[20], (DEPTH, D_MODEL), 0.02)
    return {"x": x, "a_w_in": a_w_in, "a_conv_w": a_conv_w, "a_a_log": a_a_log,
            "a_dt_bias": a_dt_bias, "a_out_norm_g": a_out_norm_g, "a_w_out": a_w_out,
            "w_kv_shared": w_kv_shared, "b_w_q": b_w_q, "b_rel_bias": b_rel_bias,
            "b_w_out": b_w_out, "moe_w_router": moe_w_router, "moe_router_bias": moe_router_bias,
            "moe_w_gate_up": moe_w_gate_up, "moe_w_down": moe_w_down,
            "moe_w_shared_gate_up": moe_w_shared_gate_up, "moe_w_shared_down": moe_w_shared_down,
            "ln_mix_g": ln_mix_g, "ln_mix_b": ln_mix_b, "ln_ffn_g": ln_ffn_g, "ln_ffn_b": ln_ffn_b}


def reference(x, a_w_in, a_conv_w, a_a_log, a_dt_bias, a_out_norm_g, a_w_out,
              w_kv_shared, b_w_q, b_rel_bias, b_w_out, moe_w_router, moe_router_bias,
              moe_w_gate_up, moe_w_down, moe_w_shared_gate_up, moe_w_shared_down,
              ln_mix_g, ln_mix_b, ln_ffn_g, ln_ffn_b):
    k_sh = None
    v_sh = None
    for layer in range(DEPTH):
        if layer < N_A_LAYERS:
            mix = gated_deltanet(x, a_w_in[layer], a_conv_w[layer], a_a_log[layer],
                                 a_dt_bias[layer], a_out_norm_g[layer], a_w_out[layer])
        else:
            if layer == N_A_LAYERS:
                k_sh, v_sh = shared_kv(x, w_kv_shared)
            j = layer - N_A_LAYERS
            mix = chunked_relpos_attention(x, b_w_q[j], b_rel_bias[j], k_sh, v_sh, b_w_out[j])
        x = layer_norm(DN_ALPHA * x + mix, ln_mix_g[layer], ln_mix_b[layer])
        ffn = moe_ffn(x, moe_w_router[layer], moe_router_bias[layer], moe_w_gate_up[layer],
                      moe_w_down[layer], moe_w_shared_gate_up[layer], moe_w_shared_down[layer])
        x = layer_norm(DN_ALPHA * x + ffn, ln_ffn_g[layer], ln_ffn_b[layer])
    return x
```

```cpp
#include <hip/hip_runtime.h>
#include <cstdio>
#include <cstdint>

#ifndef MK_SPLIT
#define MK_SPLIT 0
#endif

#define GAS __attribute__((address_space(1)))
#define LAS __attribute__((address_space(3)))
typedef unsigned short bf16;
typedef float f32x4 __attribute__((ext_vector_type(4)));
typedef float f32x2 __attribute__((ext_vector_type(2)));
typedef unsigned u32x2 __attribute__((ext_vector_type(2)));
typedef unsigned u32x4 __attribute__((ext_vector_type(4)));

constexpr int NB = 4, SEQ = 8192, NT = NB * SEQ, D = 1024;
constexpr int DNH = 8, DK = 128, DV = 128, INW = 4112, QKVW = 3072;
constexpr int AH = 16, DH = 64, CHUNK = 64, NCH = SEQ / CHUNK, LEFT = 8, BAND = (LEFT + 1) * CHUNK, RELN = 320;
constexpr int NE = 256, TOPK = 8, DE = 256;
constexpr float ALPHA = 1.41421356237f, LN_EPS = 1e-5f, NORM_EPS = 1e-6f, ROUTED_SCALE = 2.5f;
constexpr int SH0 = 327680;
constexpr int HROWS = SH0 + NT;
constexpr int NPHASE = 20;

constexpr size_t MiB = 1u << 20;
constexpr size_t O_CTL = 0, CTL_BYTES = 1 * MiB;
constexpr size_t O_XB = O_CTL + CTL_BYTES;
constexpr size_t O_XFA = O_XB + (size_t)NT * D * 2;
constexpr size_t O_XFB = O_XFA + (size_t)NT * D * 4;
constexpr size_t O_AB = O_XFB + (size_t)NT * D * 4;
constexpr size_t O_PROJ = O_AB + (size_t)NT * 16 * 4;
constexpr size_t O_O = O_PROJ + (size_t)NT * 4096 * 2;
constexpr size_t O_OG = O_O + (size_t)NT * D * 2;
constexpr size_t O_MIX = O_OG + (size_t)NT * D * 2;
constexpr size_t O_LOG = O_MIX + (size_t)NT * D * 2;
constexpr size_t O_EIDX = O_LOG + (size_t)NT * NE * 4;
constexpr size_t O_SLOT = O_EIDX + (size_t)NT * 8 * 4;
constexpr size_t O_GATE = O_SLOT + (size_t)NT * 8 * 4;
constexpr size_t O_LIST = O_GATE + (size_t)NT * 8 * 4;
constexpr size_t O_H = O_LIST + (size_t)NE * NT * 4;
constexpr size_t O_Y = O_H + (size_t)HROWS * DE * 2;
constexpr size_t O_Q = O_Y + (size_t)HROWS * D * 2;
constexpr size_t O_K = O_Q + (size_t)NT * D * 2;
constexpr size_t O_VT = O_K + (size_t)NT * D * 2;
constexpr size_t O_END = O_VT + (size_t)NT * D * 2;
constexpr int CW_BAR = 4096;
constexpr int CW_CNT = 16384;

constexpr int LDS_BYTES = 160 * 1024;

struct Args { const float* in[21]; float* out; unsigned char* ws; int ph_lo, ph_hi; };

__device__ __forceinline__ unsigned f2bf(float f) { unsigned u = __builtin_bit_cast(unsigned, f); return (u + 0x7fffu + ((u >> 16) & 1u)) >> 16; }
__device__ __forceinline__ float bf2f(unsigned b) { return __builtin_bit_cast(float, b << 16); }
__device__ __forceinline__ unsigned pk2(float lo, float hi) { return f2bf(lo) | (f2bf(hi) << 16); }
__device__ __forceinline__ float wave_sum(float v) {
#pragma unroll
    for (int o = 1; o < 64; o <<= 1) v += __shfl_xor(v, o);
    return v;
}
__device__ __forceinline__ float sigmoidf_(float x) { return 1.0f / (1.0f + __expf(-x)); }
__device__ __forceinline__ float siluf_(float x) { return x / (1.0f + __expf(-x)); }

#define XB_TMO      128
#define XB_XCNT(j)  (256  + 64 * (j))
#define XB_XSUB(j)  (1280 + 64 * (j))
#define XB_XGEN(j)  (2304 + 64 * (j))
#define XB_TOP      3328
#define XB_TOPGEN   3392
#define XCD_BAR_WORDS 3456
#define XB_SPIN_CAP (1u << 18)
__device__ __forceinline__ unsigned xb_ld(unsigned* p)              { return __hip_atomic_load(p, __ATOMIC_RELAXED, __HIP_MEMORY_SCOPE_AGENT); }
__device__ __forceinline__ unsigned xb_add(unsigned* p, unsigned v) { return __hip_atomic_fetch_add(p, v, __ATOMIC_RELAXED, __HIP_MEMORY_SCOPE_AGENT); }
__device__ __forceinline__ unsigned xb_xcc_id() { return (unsigned)__builtin_amdgcn_s_getreg((3 << 11) | 20) & 0xFu; }
#define XB_SPIN(cond, bar) do { unsigned _sp = 0; while (cond) { __builtin_amdgcn_s_sleep(1); \
    if ((++_sp & 255u) == 0u) { if (xb_ld(&(bar)[XB_TMO])) break; if (_sp > XB_SPIN_CAP) { atomicAdd(&(bar)[XB_TMO], 1u); break; } } } } while (0)
struct XcdBarrier { unsigned* bar; unsigned x; volatile LAS unsigned* st; };
__device__ __forceinline__ XcdBarrier xcd_barrier_post(unsigned* bar, volatile LAS unsigned* st) {
    XcdBarrier b; b.bar = bar; b.x = xb_xcc_id(); b.st = st;
    if (threadIdx.x == 0) (void)xb_add(&bar[XB_XCNT(b.x)], 1u);
    return b;
}
__device__ __forceinline__ void xcd_barrier_complete(unsigned* bar, unsigned x, unsigned& nloc, unsigned& nx) {
    const unsigned G = gridDim.x * gridDim.y * gridDim.z;
    unsigned sum, cnt, mine, sp = 0u;
    for (;;) {
        sum = 0u; cnt = 0u; mine = 0u;
#pragma unroll
        for (unsigned j = 0; j < 16; ++j) { const unsigned c = xb_ld(&bar[XB_XCNT(j)]); sum += c; cnt += (c > 0u) ? 1u : 0u; mine = (j == x) ? c : mine; }
        if (sum == G) break;
        __builtin_amdgcn_s_sleep(1);
        if ((++sp & 255u) == 0u) { if (xb_ld(&bar[XB_TMO])) break; if (sp > XB_SPIN_CAP) { atomicAdd(&bar[XB_TMO], 1u); break; } }
    }
    nloc = mine > 0u ? mine : 1u; nx = cnt > 0u ? cnt : 1u;
}
__device__ __forceinline__ void xcd_barrier(const XcdBarrier& b) {
    asm volatile("s_waitcnt vmcnt(0)" ::: "memory");
    __syncthreads();
    if (threadIdx.x == 0) {
        unsigned* bar = b.bar;
        __builtin_amdgcn_s_waitcnt(0);
        unsigned nloc = b.st[0], nx = b.st[1];
        if (nloc == 0u) { xcd_barrier_complete(bar, b.x, nloc, nx); b.st[0] = nloc; b.st[1] = nx; }
        const unsigned old = xb_add(&bar[XB_XSUB(b.x)], 1u);
        const unsigned gen = old / nloc;
        if (old + 1u == (gen + 1u) * nloc) {
            __builtin_amdgcn_fence(__ATOMIC_RELEASE, "agent");
            asm volatile("s_waitcnt vmcnt(0)" ::: "memory");
            const unsigned og = xb_add(&bar[XB_TOP], 1u);
            const unsigned tg = og / nx;
            if (og + 1u == (tg + 1u) * nx) xb_add(&bar[XB_TOPGEN], 1u);
            else XB_SPIN(xb_ld(&bar[XB_TOPGEN]) == tg, bar);
            __builtin_amdgcn_fence(__ATOMIC_ACQUIRE, "agent");
            xb_add(&bar[XB_XGEN(b.x)], 1u);
            asm volatile("s_waitcnt vmcnt(0)" ::: "memory");
        } else {
            XB_SPIN(xb_ld(&bar[XB_XGEN(b.x)]) == gen, bar);
            __builtin_amdgcn_fence(__ATOMIC_ACQUIRE, "agent");
            asm volatile("s_waitcnt vmcnt(0)" ::: "memory");
        }
    }
    __syncthreads();
}

struct Ctx {
    LAS unsigned char* lds; unsigned char* ws;
    int tid, lane, wave, bid, G;
};
#define WSP(T, off) ((T*)(c.ws + (off)))

__device__ __forceinline__ void ph_prologue(const Ctx& c, const Args& a) {
    LAS float* W = (LAS float*)c.lds;
    const float* win = a.in[1];
    for (int i = c.tid; i < 1024 * 16; i += 512) { const int k = i >> 4, j = i & 15; W[k * 20 + j] = win[(size_t)k * INW + 4096 + j]; }
    __syncthreads();
    const float* x = a.in[0]; bf16* xb = WSP(bf16, O_XB); float* ab = WSP(float, O_AB);
    for (int row = c.bid * 8 + c.wave; row < NT; row += c.G * 8) {
        float acc[16];
#pragma unroll
        for (int n = 0; n < 16; ++n) acc[n] = 0.f;
#pragma unroll 1
        for (int j = 0; j < 4; ++j) {
            const f32x4 v = ((const f32x4*)(x + (size_t)row * D))[c.lane + 64 * j];
            u32x2 w2; w2.x = pk2(v.x, v.y); w2.y = pk2(v.z, v.w); ((u32x2*)(xb + (size_t)row * D))[c.lane + 64 * j] = w2;
#pragma unroll
            for (int i = 0; i < 4; ++i) {
                const int k = 4 * c.lane + 256 * j + i; const float xv = v[i];
#pragma unroll
                for (int q = 0; q < 4; ++q) { const f32x4 w = *(const LAS f32x4*)(W + k * 20 + 4 * q);
                    acc[4 * q + 0] += xv * w.x; acc[4 * q + 1] += xv * w.y; acc[4 * q + 2] += xv * w.z; acc[4 * q + 3] += xv * w.w; }
            }
        }
        float r = 0.f;
#pragma unroll
        for (int n = 0; n < 16; ++n) { const float s = wave_sum(acc[n]); r = (c.lane == n) ? s : r; }
        if (c.lane < 16) ab[(size_t)row * 16 + c.lane] = r;
    }
}

template <class AF, class BF, class EF>
__device__ __forceinline__ void gg_tile(const Ctx& c, int K, const AF& afn, const BF& bfn, const EF& efn) {
    LAS float* As = (LAS float*)c.lds;
    LAS float* Bs = As + 16 * 132;
    const int ty = c.tid >> 4, tx = c.tid & 15;
    const int ar = c.tid >> 2, ak = (c.tid & 3) * 4, bk = c.tid >> 5, bq = c.tid & 31;
    float acc[4][8];
#pragma unroll
    for (int i = 0; i < 4; ++i)
#pragma unroll
        for (int j = 0; j < 8; ++j) acc[i][j] = 0.f;
    for (int k0 = 0; k0 < K; k0 += 16) {
        const f32x4 av = afn(ar, k0 + ak);
        const f32x4 bv = bfn(k0 + bk, bq);
        __syncthreads();
        As[(ak + 0) * 132 + ar] = av.x; As[(ak + 1) * 132 + ar] = av.y; As[(ak + 2) * 132 + ar] = av.z; As[(ak + 3) * 132 + ar] = av.w;
        *(LAS f32x4*)(Bs + bk * 128 + bq * 4) = bv;
        __syncthreads();
#pragma unroll 4
        for (int kk = 0; kk < 16; ++kk) {
            const f32x4 a4 = *(const LAS f32x4*)(As + kk * 132 + ty * 4);
            const f32x4 b0 = *(const LAS f32x4*)(Bs + kk * 128 + tx * 8), b1 = *(const LAS f32x4*)(Bs + kk * 128 + tx * 8 + 4);
#pragma unroll
            for (int i = 0; i < 4; ++i) {
                acc[i][0] += a4[i] * b0.x; acc[i][1] += a4[i] * b0.y; acc[i][2] += a4[i] * b0.z; acc[i][3] += a4[i] * b0.w;
                acc[i][4] += a4[i] * b1.x; acc[i][5] += a4[i] * b1.y; acc[i][6] += a4[i] * b1.z; acc[i][7] += a4[i] * b1.w;
            }
        }
    }
#pragma unroll
    for (int i = 0; i < 4; ++i) efn(ty * 4 + i, tx * 8, acc[i]);
}
__device__ __forceinline__ f32x4 ld_bf16x4(const bf16* p) { const u32x2 w = *(const u32x2*)p; return (f32x4){bf2f(w.x & 0xffffu), bf2f(w.x >> 16), bf2f(w.y & 0xffffu), bf2f(w.y >> 16)}; }
struct ALin { const bf16* base; int lda; __device__ __forceinline__ f32x4 operator()(int r, int k) const { return ld_bf16x4(base + (size_t)r * lda + k); } };
struct AGather { const bf16* base; int lda; const LAS int* rows; __device__ __forceinline__ f32x4 operator()(int r, int k) const { return ld_bf16x4(base + (size_t)rows[r] * lda + k); } };
struct BPlain { const float* B; int ldb; __device__ __forceinline__ f32x4 operator()(int k, int q) const { return *(const f32x4*)(B + (size_t)k * ldb + 4 * q); } };
struct BGateUp { const float* B; int ldb; int up_off; __device__ __forceinline__ f32x4 operator()(int k, int q) const {
    const f32x2 g = *(const f32x2*)(B + (size_t)k * ldb + 2 * q), u = *(const f32x2*)(B + (size_t)k * ldb + up_off + 2 * q); return (f32x4){g.x, u.x, g.y, u.y}; } };
struct EBf16 { bf16* C; int ldc; float scale; __device__ __forceinline__ void operator()(int r, int cb, const float (&v)[8]) const {
    u32x4 w; w.x = pk2(v[0] * scale, v[1] * scale); w.y = pk2(v[2] * scale, v[3] * scale); w.z = pk2(v[4] * scale, v[5] * scale); w.w = pk2(v[6] * scale, v[7] * scale);
    *(u32x4*)(C + (size_t)r * ldc + cb) = w; } };
struct EBf16T { bf16* C; int ldc; __device__ __forceinline__ void operator()(int r, int cb, const float (&v)[8]) const {
#pragma unroll
    for (int j = 0; j < 8; ++j) C[(size_t)(cb + j) * ldc + r] = (bf16)f2bf(v[j]); } };
struct EF32 { float* C; int ldc; __device__ __forceinline__ void operator()(int r, int cb, const float (&v)[8]) const {
    *(f32x4*)(C + (size_t)r * ldc + cb) = (f32x4){v[0], v[1], v[2], v[3]}; *(f32x4*)(C + (size_t)r * ldc + cb + 4) = (f32x4){v[4], v[5], v[6], v[7]}; } };
struct ESwiglu { bf16* H; int ldh; __device__ __forceinline__ void operator()(int r, int cb, const float (&v)[8]) const {
    u32x2 w; w.x = pk2(siluf_(v[0]) * v[1], siluf_(v[2]) * v[3]); w.y = pk2(siluf_(v[4]) * v[5], siluf_(v[6]) * v[7]);
    *(u32x2*)(H + (size_t)r * ldh + (cb >> 1)) = w; } };

__device__ __forceinline__ void ph_inproj(const Ctx& c, const Args& a) {
    const bf16* xb = WSP(bf16, O_XB); bf16* proj = WSP(bf16, O_PROJ);
    for (int u = c.bid; u < (NT / 128) * 32; u += c.G) {
        const int mb = u >> 5, nb = u & 31;
        gg_tile(c, D, ALin{xb + (size_t)mb * 128 * D, D}, BPlain{a.in[1] + nb * 128, INW}, EBf16{proj + (size_t)mb * 128 * 4096 + nb * 128, 4096, 1.f});
    }
}

__device__ __forceinline__ void ph_delta_golden(const Ctx& c, const Args& a) {
    LAS float* raw = (LAS float*)c.lds;
    LAS float* red = raw + 384;
    LAS float* red2 = red + 512;
    LAS float* nrm = red2 + 512;
    const bf16* proj = WSP(bf16, O_PROJ); const float* ab = WSP(float, O_AB); bf16* O = WSP(bf16, O_O);
    const float* convw = a.in[2];
    for (int bh = c.bid; bh < NB * DNH; bh += c.G) {
        const int b = bh / DNH, h = bh % DNH;
        const int e = c.tid & 127, part = c.tid >> 7;
        float S[32];
#pragma unroll
        for (int i = 0; i < 32; ++i) S[i] = 0.f;
        const int ch = c.tid;
        const int col = (ch >> 7) * 1024 + h * 128 + (ch & 127);
        float w0 = 0, w1 = 0, w2 = 0, w3 = 0, x0 = 0, x1 = 0, x2 = 0;
        if (ch < 384) { w0 = convw[0 * QKVW + col]; w1 = convw[1 * QKVW + col]; w2 = convw[2 * QKVW + col]; w3 = convw[3 * QKVW + col]; }
        const float Ah = __expf(a.in[3][h]), dtb = a.in[4][h];
        for (int t = 0; t < SEQ; ++t) {
            const size_t tok = (size_t)b * SEQ + t;
            if (ch < 384) { const float x3 = bf2f(proj[tok * 4096 + col]); const float y = x0 * w0 + x1 * w1 + x2 * w2 + x3 * w3; raw[ch] = siluf_(y); x0 = x1; x1 = x2; x2 = x3; }
            __syncthreads();
            if (c.wave < 2) { const float v0 = raw[c.wave * 128 + c.lane], v1 = raw[c.wave * 128 + 64 + c.lane]; const float s = wave_sum(v0 * v0 + v1 * v1); if (c.lane == 0) nrm[c.wave] = s; }
            __syncthreads();
            const float rq = rsqrtf(nrm[0] + NORM_EPS) * 0.08838834764831845f, rk = rsqrtf(nrm[1] + NORM_EPS);
            const float av = ab[tok * 16 + h], bv = ab[tok * 16 + 8 + h];
            const float xx = av + dtb; const float sp = xx > 20.f ? xx : log1pf(__expf(xx));
            const float dec = __expf(-Ah * sp), beta = sigmoidf_(bv);
            float r = 0.f;
#pragma unroll
            for (int i = 0; i < 32; ++i) { S[i] *= dec; r += raw[128 + part * 32 + i] * rk * S[i]; }
            red[part * 128 + e] = r;
            __syncthreads();
            const float rr = red[e] + red[128 + e] + red[256 + e] + red[384 + e];
            const float vnew = beta * (raw[256 + e] - rr);
            float o = 0.f;
#pragma unroll
            for (int i = 0; i < 32; ++i) { S[i] += raw[128 + part * 32 + i] * rk * vnew; o += raw[part * 32 + i] * rq * S[i]; }
            red2[part * 128 + e] = o;
            __syncthreads();
            if (part == 0) { const float oo = red2[e] + red2[128 + e] + red2[256 + e] + red2[384 + e]; O[tok * D + h * 128 + e] = (bf16)f2bf(oo); }
        }
        __syncthreads();
    }
}

__device__ __forceinline__ void ph_gatednorm(const Ctx& c, const Args& a) {
    const bf16* O = WSP(bf16, O_O); const bf16* proj = WSP(bf16, O_PROJ); bf16* og = WSP(bf16, O_OG);
    const float* gn = a.in[5];
    for (int row = c.bid * 8 + c.wave; row < NT; row += c.G * 8) {
#pragma unroll
        for (int j = 0; j < 4; ++j) {
            const int col = 4 * c.lane + 256 * j;
            const f32x4 o = ld_bf16x4(O + (size_t)row * D + col), z = ld_bf16x4(proj + (size_t)row * 4096 + 3072 + col);
            float s = o.x * o.x + o.y * o.y + o.z * o.z + o.w * o.w;
#pragma unroll
            for (int m = 1; m < 32; m <<= 1) s += __shfl_xor(s, m);
            const float rs = rsqrtf(s * (1.f / 128.f) + NORM_EPS);
            const f32x4 g = *(const f32x4*)(gn + (col & 127));
            u32x2 w; w.x = pk2(o.x * rs * g.x * siluf_(z.x), o.y * rs * g.y * siluf_(z.y)); w.y = pk2(o.z * rs * g.z * siluf_(z.z), o.w * rs * g.w * siluf_(z.w));
            *(u32x2*)(og + (size_t)row * D + col) = w;
        }
    }
}

__device__ __forceinline__ void ph_proj1024(const Ctx& c, const bf16* A, const float* W, int ldw, bf16* C, float scale) {
    for (int u = c.bid; u < (NT / 128) * 8; u += c.G) {
        const int mb = u >> 3, nb = u & 7;
        gg_tile(c, D, ALin{A + (size_t)mb * 128 * D, D}, BPlain{W + nb * 128, ldw}, EBf16{C + (size_t)mb * 128 * D + nb * 128, D, scale});
    }
}

__device__ __forceinline__ void ln_finish(const Ctx& c, f32x4 (&v)[4], const float* g, const float* b, float* outf, bf16* outb, size_t row) {
    float s = 0.f;
#pragma unroll
    for (int j = 0; j < 4; ++j) s += (v[j].x + v[j].y) + (v[j].z + v[j].w);
    const float mean = wave_sum(s) * (1.f / D); float s2 = 0.f;
#pragma unroll
    for (int j = 0; j < 4; ++j) { v[j] = v[j] - mean; s2 += (v[j].x * v[j].x + v[j].y * v[j].y) + (v[j].z * v[j].z + v[j].w * v[j].w); }
    const float rstd = rsqrtf(wave_sum(s2) * (1.f / D) + LN_EPS);
#pragma unroll
    for (int j = 0; j < 4; ++j) {
        const int col = 4 * c.lane + 256 * j;
        const f32x4 gg = *(const f32x4*)(g + col), bb = *(const f32x4*)(b + col);
        const f32x4 o = v[j] * rstd * gg + bb;
        *(f32x4*)(outf + row * D + col) = o;
        if (outb) { u32x2 w; w.x = pk2(o.x, o.y); w.y = pk2(o.z, o.w); *(u32x2*)(outb + row * D + col) = w; }
    }
}
__device__ __forceinline__ void ph_ln_mix(const Ctx& c, const float* xin, const bf16* mix, const float* g, const float* b, float* outf, bf16* outb) {
    for (int row = c.bid * 8 + c.wave; row < NT; row += c.G * 8) {
        f32x4 v[4];
#pragma unroll
        for (int j = 0; j < 4; ++j) { const int col = 4 * c.lane + 256 * j; v[j] = *(const f32x4*)(xin + (size_t)row * D + col) * ALPHA + ld_bf16x4(mix + (size_t)row * D + col); }
        ln_finish(c, v, g, b, outf, outb, (size_t)row);
    }
}

__device__ __forceinline__ void ph_router_shared(const Ctx& c, const Args& a, int layer) {
    const bf16* xb = WSP(bf16, O_XB); float* logits = WSP(float, O_LOG); bf16* H = WSP(bf16, O_H);
    const float* wr = a.in[11] + (size_t)layer * D * NE; const float* wsg = a.in[15] + (size_t)layer * D * 512;
    for (int u = c.bid; u < (NT / 128) * 2; u += c.G) {
        const int mb = u >> 1, nb = u & 1;
        gg_tile(c, D, ALin{xb + (size_t)mb * 128 * D, D}, BPlain{wr + nb * 128, NE}, EF32{logits + (size_t)mb * 128 * NE + nb * 128, NE});
    }
    for (int u = c.bid; u < (NT / 128) * 4; u += c.G) {
        const int mb = u >> 2, nb = u & 3;
        gg_tile(c, D, ALin{xb + (size_t)mb * 128 * D, D}, BGateUp{wsg + nb * 64, 512, 256}, ESwiglu{H + (size_t)(SH0 + mb * 128) * DE + nb * 64, DE});
    }
}

__device__ __forceinline__ void ph_route(const Ctx& c, const Args& a, int layer) {
    LAS int* hist = (LAS int*)c.lds;
    LAS int* base = hist + 256;
    LAS int* rec_e = base + 256;
    LAS int* rec_r = rec_e + 1024;
    const float* logits = WSP(float, O_LOG); const float* rbias = a.in[12] + layer * NE;
    int* eidx = WSP(int, O_EIDX); int* slot = WSP(int, O_SLOT); float* gate = WSP(float, O_GATE); int* list = WSP(int, O_LIST);
    unsigned* counts = WSP(unsigned, O_CTL) + CW_CNT + 256 * layer;
    const float NINF = -__builtin_inff();
    for (int blk = c.bid; blk < NT / 128; blk += c.G) {
        if (c.tid < 256) hist[c.tid] = 0;
        __syncthreads();
        for (int i = 0; i < 16; ++i) {
            const int tl = c.wave * 16 + i, tok = blk * 128 + tl;
            const f32x4 lg = *(const f32x4*)(logits + (size_t)tok * NE + 4 * c.lane);
            const f32x4 bs = *(const f32x4*)(rbias + 4 * c.lane);
            float sc[4], sel[4];
#pragma unroll
            for (int j = 0; j < 4; ++j) { sc[j] = sigmoidf_(lg[j]); sel[j] = sc[j] + bs[j]; }
            float m1 = fmaxf(sel[0], sel[1]), m2 = fminf(sel[0], sel[1]);
#pragma unroll
            for (int j = 2; j < 4; ++j) { const float v = sel[j]; m2 = fmaxf(m2, fminf(m1, v)); m1 = fmaxf(m1, v); }
#pragma unroll
            for (int o = 1; o < 8; o <<= 1) { const float o1 = __shfl_xor(m1, o), o2 = __shfl_xor(m2, o); m2 = fmaxf(fminf(m1, o1), fmaxf(m2, o2)); m1 = fmaxf(m1, o1); }
            const float gs = m1 + m2; const int myg = c.lane >> 3; int rank = 0;
#pragma unroll
            for (int j = 0; j < 8; ++j) { const float s = __shfl(gs, 8 * j); rank += (s > gs || (s == gs && j < myg)) ? 1 : 0; }
            if (rank >= 4) { sel[0] = NINF; sel[1] = NINF; sel[2] = NINF; sel[3] = NINF; }
            float wsum = 0.f, myw = 0.f; int mye = 0;
#pragma unroll
            for (int r = 0; r < 8; ++r) {
                float bv = sel[0]; int bi = 4 * c.lane;
#pragma unroll
                for (int j = 1; j < 4; ++j) if (sel[j] > bv) { bv = sel[j]; bi = 4 * c.lane + j; }
#pragma unroll
                for (int o = 32; o >= 1; o >>= 1) { const float ov = __shfl_xor(bv, o); const int oi = __shfl_xor(bi, o); if (ov > bv || (ov == bv && oi < bi)) { bv = ov; bi = oi; } }
                const int own = bi >> 2, jj = bi & 3;
                float mine = sc[0]; mine = (jj == 1) ? sc[1] : mine; mine = (jj == 2) ? sc[2] : mine; mine = (jj == 3) ? sc[3] : mine;
                const float w = __shfl(mine, own);
                if (c.lane == own) { sel[0] = (jj == 0) ? NINF : sel[0]; sel[1] = (jj == 1) ? NINF : sel[1]; sel[2] = (jj == 2) ? NINF : sel[2]; sel[3] = (jj == 3) ? NINF : sel[3]; }
                wsum += w; if (c.lane == r) { myw = w; mye = bi; }
            }
            if (c.lane < 8) {
                const float gt = myw / wsum * ROUTED_SCALE;
                eidx[(size_t)tok * 8 + c.lane] = mye; gate[(size_t)tok * 8 + c.lane] = gt;
                rec_e[tl * 8 + c.lane] = mye; rec_r[tl * 8 + c.lane] = __hip_atomic_fetch_add(&hist[mye], 1, __ATOMIC_RELAXED, __HIP_MEMORY_SCOPE_WORKGROUP);
            }
        }
        __syncthreads();
        if (c.tid < 256) { const int n = hist[c.tid]; base[c.tid] = n ? (int)atomicAdd(&counts[c.tid], (unsigned)n) : 0; }
        __syncthreads();
        for (int i = c.tid; i < 1024; i += 512) {
            const int e = rec_e[i], s = base[e] + rec_r[i], tok = blk * 128 + (i >> 3);
            slot[(size_t)tok * 8 + (i & 7)] = s; list[(size_t)e * NT + s] = tok;
        }
        __syncthreads();
    }
}

__device__ __forceinline__ void moe_tables(const Ctx& c, int layer, LAS int* ts, LAS int* cnt) {
    const unsigned* counts = WSP(unsigned, O_CTL) + CW_CNT + 256 * layer;
    if (c.tid < 256) cnt[c.tid] = (int)__hip_atomic_load(counts + c.tid, __ATOMIC_RELAXED, __HIP_MEMORY_SCOPE_AGENT);
    __syncthreads();
    if (c.tid == 0) { int s = 0; for (int e = 0; e < 256; ++e) { ts[e] = s; s += (cnt[e] + 255) >> 8; } ts[256] = s; }
    __syncthreads();
}
__device__ __forceinline__ int find_expert(const LAS int* ts, int mt) { int lo = 0, hi = 255; while (lo < hi) { const int mid = (lo + hi + 1) >> 1; if (ts[mid] <= mt) lo = mid; else hi = mid - 1; } return lo; }

__device__ __forceinline__ void ph_moe_gu(const Ctx& c, const Args& a, int layer) {
    LAS int* ts = (LAS int*)(c.lds + 20480); LAS int* cnt = ts + 260; LAS int* rows = cnt + 256;
    moe_tables(c, layer, ts, cnt);
    const bf16* xb = WSP(bf16, O_XB); bf16* H = WSP(bf16, O_H); const int* list = WSP(int, O_LIST);
    const int ntile = ts[256];
    for (int u = c.bid; u < ntile * 8; u += c.G) {
        const int mt = u >> 3, sub = u & 7, rh = sub >> 2, cb = sub & 3;
        int e = find_expert(ts, mt);
        while (ts[e + 1] <= mt) ++e;
        __syncthreads();
        if (c.tid < 128) { const int s = (mt - ts[e]) * 256 + rh * 128 + c.tid; rows[c.tid] = s < cnt[e] ? list[(size_t)e * NT + s] : 0; }
        __syncthreads();
        const float* W = a.in[13] + ((size_t)layer * NE + e) * D * 512;
        gg_tile(c, D, AGather{xb, D, rows}, BGateUp{W + cb * 64, 512, 256}, ESwiglu{H + (size_t)(mt * 256 + rh * 128) * DE + cb * 64, DE});
    }
}
__device__ __forceinline__ void ph_moe_down(const Ctx& c, const Args& a, int layer) {
    LAS int* ts = (LAS int*)(c.lds + 20480); LAS int* cnt = ts + 260;
    moe_tables(c, layer, ts, cnt);
    const bf16* H = WSP(bf16, O_H); bf16* Y = WSP(bf16, O_Y);
    const int ntile = ts[256];
    for (int u = c.bid; u < (ntile + NT / 256) * 16; u += c.G) {
        const int mt = u >> 4, sub = u & 15, rh = sub >> 3, nb = sub & 7;
        const float* W; size_t row0;
        if (mt < ntile) { int e = find_expert(ts, mt); while (ts[e + 1] <= mt) ++e; W = a.in[14] + ((size_t)layer * NE + e) * DE * D; row0 = (size_t)mt * 256 + rh * 128; }
        else { W = a.in[16] + (size_t)layer * DE * D; row0 = (size_t)SH0 + (size_t)(mt - ntile) * 256 + rh * 128; }
        gg_tile(c, DE, ALin{H + row0 * DE, DE}, BPlain{W + nb * 128, D}, EBf16{Y + row0 * D + nb * 128, D, 1.f});
    }
}
__device__ __forceinline__ void ph_combine_ln(const Ctx& c, const Args& a, int layer, const float* xin, float* outf, bf16* outb) {
    LAS int* ts = (LAS int*)(c.lds + 20480); LAS int* cnt = ts + 260;
    moe_tables(c, layer, ts, cnt);
    const bf16* Y = WSP(bf16, O_Y); const int* eidx = WSP(int, O_EIDX); const int* slot = WSP(int, O_SLOT); const float* gate = WSP(float, O_GATE);
    const float* g = a.in[19] + layer * D; const float* b = a.in[20] + layer * D;
    for (int row = c.bid * 8 + c.wave; row < NT; row += c.G * 8) {
        int me = 0, ms = 0; float mg = 0.f;
        if (c.lane < 8) { me = eidx[(size_t)row * 8 + c.lane]; ms = slot[(size_t)row * 8 + c.lane]; mg = gate[(size_t)row * 8 + c.lane]; }
        const int myrow = (c.lane < 8) ? ts[me] * 256 + ms : 0;
        f32x4 v[4];
#pragma unroll
        for (int j = 0; j < 4; ++j) { const int col = 4 * c.lane + 256 * j; v[j] = *(const f32x4*)(xin + (size_t)row * D + col) * ALPHA + ld_bf16x4(Y + ((size_t)SH0 + row) * D + col); }
#pragma unroll
        for (int k = 0; k < 8; ++k) {
            const int yr = __shfl(myrow, k); const float gk = __shfl(mg, k);
#pragma unroll
            for (int j = 0; j < 4; ++j) { const int col = 4 * c.lane + 256 * j; v[j] += ld_bf16x4(Y + (size_t)yr * D + col) * gk; }
        }
        ln_finish(c, v, g, b, outf, outb, (size_t)row);
    }
}

__device__ __forceinline__ void ph_qkv(const Ctx& c, const Args& a) {
    const bf16* xb = WSP(bf16, O_XB); bf16* Q = WSP(bf16, O_Q); bf16* Kb = WSP(bf16, O_K); bf16* VT = WSP(bf16, O_VT);
    for (int u = c.bid; u < (NT / 128) * 24; u += c.G) {
        const int mb = u / 24, nb = u % 24;
        if (nb < 8) gg_tile(c, D, ALin{xb + (size_t)mb * 128 * D, D}, BPlain{a.in[8] + nb * 128, D}, EBf16{Q + (size_t)mb * 128 * D + nb * 128, D, 0.125f});
        else if (nb < 16) gg_tile(c, D, ALin{xb + (size_t)mb * 128 * D, D}, BPlain{a.in[7] + (nb - 8) * 128, 2048}, EBf16{Kb + (size_t)mb * 128 * D + (nb - 8) * 128, D, 1.f});
        else gg_tile(c, D, ALin{xb + (size_t)mb * 128 * D, D}, BPlain{a.in[7] + 1024 + (nb - 16) * 128, 2048}, EBf16T{VT + (size_t)(nb - 16) * 128 * NT + (size_t)mb * 128, NT});
    }
}
__device__ __forceinline__ void ph_attn_golden(const Ctx& c, const Args& a) {
    const bf16* Q = WSP(bf16, O_Q); const bf16* Kb = WSP(bf16, O_K); const bf16* VT = WSP(bf16, O_VT); bf16* AO = WSP(bf16, O_OG);
    const float* relb = a.in[9];
    for (int u = c.bid * 8 + c.wave; u < NB * NCH * AH; u += c.G * 8) {
        const int h = u % AH, bc = u / AH, ch = bc % NCH, b = bc / NCH;
        const size_t tok = (size_t)b * SEQ + ch * 64 + c.lane;
        float q[64], o[64];
#pragma unroll
        for (int d = 0; d < 64; d += 4) { const f32x4 t = ld_bf16x4(Q + tok * D + h * 64 + d); q[d] = t.x; q[d + 1] = t.y; q[d + 2] = t.z; q[d + 3] = t.w; }
#pragma unroll
        for (int d = 0; d < 64; ++d) o[d] = 0.f;
        float m = -1e30f, l = 0.f;
        const int j0 = (ch < LEFT) ? (LEFT - ch) * 64 : 0;
        for (int j = j0; j < BAND; ++j) {
            const int kpos = ch * 64 - LEFT * 64 + j;
            const bf16* kr = Kb + ((size_t)b * SEQ + kpos) * D + h * 64;
            float s = 0.f;
#pragma unroll
            for (int d = 0; d < 64; d += 4) { const f32x4 t = ld_bf16x4(kr + d); s += q[d] * t.x + q[d + 1] * t.y + q[d + 2] * t.z + q[d + 3] * t.w; }
            int rel = c.lane + LEFT * 64 - j; rel = rel < -63 ? -63 : (rel > 256 ? 256 : rel);
            s += relb[h * RELN + rel + 63];
            const float mn = fmaxf(m, s), corr = __expf(m - mn), p = __expf(s - mn);
            l = l * corr + p; m = mn;
            const bf16* vc = VT + (size_t)(h * 64) * NT + (size_t)b * SEQ + kpos;
#pragma unroll
            for (int d = 0; d < 64; ++d) o[d] = o[d] * corr + p * bf2f(vc[(size_t)d * NT]);
        }
        const float il = 1.f / l;
#pragma unroll
        for (int d = 0; d < 64; d += 4) { u32x2 w; w.x = pk2(o[d] * il, o[d + 1] * il); w.y = pk2(o[d + 2] * il, o[d + 3] * il); *(u32x2*)(AO + tok * D + h * 64 + d) = w; }
    }
}

__global__ void __launch_bounds__(512, 2) fwd(Args args) {
    extern __shared__ __attribute__((aligned(16))) unsigned char lds_raw[];
    Ctx c; c.lds = (LAS unsigned char*)lds_raw; c.ws = args.ws;
    c.tid = threadIdx.x; c.lane = c.tid & 63; c.wave = __builtin_amdgcn_readfirstlane(c.tid >> 6); c.bid = blockIdx.x; c.G = gridDim.x;
    volatile LAS unsigned* xbw = (volatile LAS unsigned*)(c.lds + LDS_BYTES - 16);
    if (c.tid == 0) { xbw[0] = 0u; xbw[1] = 0u; }
    __syncthreads();
    XcdBarrier bar; bar.bar = (unsigned*)(args.ws + O_CTL) + CW_BAR; bar.x = 0; bar.st = xbw;
#if !MK_SPLIT
    bar = xcd_barrier_post((unsigned*)(args.ws + O_CTL) + CW_BAR, xbw);
#endif
    const int lo = args.ph_lo, hi = args.ph_hi;
#ifndef PH_MASK
#define PH_MASK 0xFFFFFu
#endif
#define IN(k) (((PH_MASK >> (k)) & 1u) && lo <= (k) && (k) < hi)
#if MK_SPLIT
#define SEAM(k) do { } while (0)
#else
#define SEAM(k) do { if (IN(k) && IN((k) + 1)) xcd_barrier(bar); } while (0)
#endif
    float* XFA = (float*)(args.ws + O_XFA); float* XFB = (float*)(args.ws + O_XFB); bf16* XBp = (bf16*)(args.ws + O_XB);
    bf16* OG = (bf16*)(args.ws + O_OG); bf16* MIX = (bf16*)(args.ws + O_MIX);
    if (IN(0)) ph_prologue(c, args);
    SEAM(0);
    if (IN(1)) ph_inproj(c, args);
    SEAM(1);
    if (IN(2)) ph_delta_golden(c, args);
    SEAM(2);
    if (IN(3)) ph_gatednorm(c, args);
    SEAM(3);
    if (IN(4)) ph_proj1024(c, OG, args.in[6], D, MIX, 1.f);
    SEAM(4);
    if (IN(5)) ph_ln_mix(c, args.in[0], MIX, args.in[17], args.in[18], XFA, XBp);
    SEAM(5);
    if (IN(6)) ph_router_shared(c, args, 0);
    SEAM(6);
    if (IN(7)) ph_route(c, args, 0);
    SEAM(7);
    if (IN(8)) ph_moe_gu(c, args, 0);
    SEAM(8);
    if (IN(9)) ph_moe_down(c, args, 0);
    SEAM(9);
    if (IN(10)) ph_combine_ln(c, args, 0, XFA, XFB, XBp);
    SEAM(10);
    if (IN(11)) ph_qkv(c, args);
    SEAM(11);
    if (IN(12)) ph_attn_golden(c, args);
    SEAM(12);
    if (IN(13)) ph_proj1024(c, OG, args.in[10], D, MIX, 1.f);
    SEAM(13);
    if (IN(14)) ph_ln_mix(c, XFB, MIX, args.in[17] + D, args.in[18] + D, XFA, XBp);
    SEAM(14);
    if (IN(15)) ph_router_shared(c, args, 1);
    SEAM(15);
    if (IN(16)) ph_route(c, args, 1);
    SEAM(16);
    if (IN(17)) ph_moe_gu(c, args, 1);
    SEAM(17);
    if (IN(18)) ph_moe_down(c, args, 1);
    SEAM(18);
    if (IN(19)) ph_combine_ln(c, args, 1, XFA, args.out, nullptr);
#undef IN
#undef SEAM
}

extern "C" void kernel_launch(void* const* d_in, const int* in_sizes, int n_in, void* d_out, int out_size, void* d_ws, size_t ws_size, hipStream_t stream) {
    static int grid = 0;
    if (grid == 0) {
        if (n_in != 21 || out_size != NT * D || ws_size < O_END) { fprintf(stderr, "kernel_launch: unexpected problem: n_in %d out %d ws %zu (need %zu)\n", n_in, out_size, ws_size, (size_t)O_END); grid = -1; return; }
        int dev = 0, cus = 0, per_cu = 0;
        if (hipGetDevice(&dev) != hipSuccess || hipDeviceGetAttribute(&cus, hipDeviceAttributeMultiprocessorCount, dev) != hipSuccess) { grid = -1; return; }
        if (hipFuncSetAttribute((const void*)fwd, hipFuncAttributeMaxDynamicSharedMemorySize, LDS_BYTES) != hipSuccess) { fprintf(stderr, "kernel_launch: hipFuncSetAttribute failed\n"); grid = -1; return; }
        if (hipOccupancyMaxActiveBlocksPerMultiprocessor(&per_cu, (const void*)fwd, 512, LDS_BYTES) != hipSuccess || per_cu < 1) fprintf(stderr, "kernel_launch: occupancy query says %d\n", per_cu);
        (void)hipGetLastError();
        grid = cus;
    }
    if (grid < 0) return;
    (void)hipMemsetAsync((char*)d_ws + O_CTL, 0, CTL_BYTES, stream);
    Args a{};
    for (int i = 0; i < 21; ++i) a.in[i] = (const float*)d_in[i];
    a.out = (float*)d_out; a.ws = (unsigned char*)d_ws;
#if MK_SPLIT
    for (int p = 0; p < NPHASE; ++p) { a.ph_lo = p; a.ph_hi = p + 1; hipLaunchKernelGGL(fwd, dim3(grid), dim3(512), LDS_BYTES, stream, a); }
#else
    a.ph_lo = 0; a.ph_hi = NPHASE; hipLaunchKernelGGL(fwd, dim3(grid), dim3(512), LDS_BYTES, stream, a);
#endif
}
```

```cpp
#include <hip/hip_runtime.h>
#include <cstdio>
#include <cstdint>

#ifndef DELTA_GOLDEN
#define DELTA_GOLDEN 0
#endif
#ifndef MK_SPLIT
#define MK_SPLIT 0
#endif

#define GAS __attribute__((address_space(1)))
#define LAS __attribute__((address_space(3)))
typedef unsigned short bf16;
typedef float f32x4 __attribute__((ext_vector_type(4)));
typedef float f32x2 __attribute__((ext_vector_type(2)));
typedef unsigned u32x2 __attribute__((ext_vector_type(2)));
typedef unsigned u32x4 __attribute__((ext_vector_type(4)));

constexpr int NB = 4, SEQ = 8192, NT = NB * SEQ, D = 1024;
constexpr int DNH = 8, DK = 128, DV = 128, INW = 4112, QKVW = 3072;
constexpr int AH = 16, DH = 64, CHUNK = 64, NCH = SEQ / CHUNK, LEFT = 8, BAND = (LEFT + 1) * CHUNK, RELN = 320;
constexpr int NE = 256, TOPK = 8, DE = 256;
constexpr float ALPHA = 1.41421356237f, LN_EPS = 1e-5f, NORM_EPS = 1e-6f, ROUTED_SCALE = 2.5f;
constexpr int SH0 = 327680;
constexpr int HROWS = SH0 + NT;
constexpr int NPHASE = 21;

constexpr size_t MiB = 1u << 20;
constexpr size_t O_CTL = 0, CTL_BYTES = 1 * MiB;
constexpr size_t O_XB = O_CTL + CTL_BYTES;
constexpr size_t O_XFA = O_XB + (size_t)NT * D * 2;
constexpr size_t O_XFB = O_XFA + (size_t)NT * D * 4;
constexpr size_t O_AB = O_XFB + (size_t)NT * D * 4;
constexpr size_t O_PROJ = O_AB + (size_t)NT * 16 * 4;
constexpr size_t O_O = O_PROJ + (size_t)NT * 4096 * 2;
constexpr size_t O_OG = O_O + (size_t)NT * D * 2;
constexpr size_t O_MIX = O_OG + (size_t)NT * D * 2;
constexpr size_t O_LOG = O_MIX + (size_t)NT * D * 2;
constexpr size_t O_EIDX = O_LOG + (size_t)NT * NE * 4;
constexpr size_t O_SLOT = O_EIDX + (size_t)NT * 8 * 4;
constexpr size_t O_GATE = O_SLOT + (size_t)NT * 8 * 4;
constexpr size_t O_LIST = O_GATE + (size_t)NT * 8 * 4;
constexpr size_t O_H = O_LIST + (size_t)NE * NT * 4;
constexpr size_t O_Y = O_H + (size_t)HROWS * DE * 2;
constexpr size_t O_Q = O_Y + (size_t)HROWS * D * 2;
constexpr size_t O_K = O_Q + (size_t)NT * D * 2;
constexpr size_t O_VT = O_K + (size_t)NT * D * 2;
constexpr size_t O_WIN = O_VT + (size_t)NT * D * 2;
constexpr size_t O_WOA = O_WIN + (size_t)4096 * D * 2;
constexpr size_t O_WQK = O_WOA + (size_t)D * D * 2;
constexpr size_t O_WV = O_WQK + (size_t)2048 * D * 2;
constexpr size_t O_WOB = O_WV + (size_t)D * D * 2;
constexpr size_t O_WRS = O_WOB + (size_t)D * D * 2;
constexpr size_t O_WSD = O_WRS + (size_t)2 * 768 * D * 2;
constexpr size_t O_WGU = O_WSD + (size_t)2 * D * DE * 2;
constexpr size_t O_WD = O_WGU + (size_t)2 * NE * 512 * D * 2;
constexpr size_t O_DU = O_WD + (size_t)2 * NE * D * DE * 2;
constexpr size_t DU_NW = 0, DU_QG = 16384, DU_KDT = 32768, DU_P = 49152, DU_U = 57344, DU_BYTES = 73728;
constexpr int NUNIT = NB * DNH * NCH;
constexpr size_t O_EGL = O_DU + (size_t)NUNIT * DU_BYTES;
constexpr size_t O_END = O_EGL + (size_t)NUNIT * 4;
constexpr int CW_BAR = 4096;
constexpr int CW_CNT = 16384;

constexpr int LDS_BYTES = 160 * 1024;

struct Args { const float* in[21]; float* out; unsigned char* ws; int ph_lo, ph_hi; };

__device__ __forceinline__ unsigned f2bf(float f) { unsigned u = __builtin_bit_cast(unsigned, f); return (u + 0x7fffu + ((u >> 16) & 1u)) >> 16; }
__device__ __forceinline__ float bf2f(unsigned b) { return __builtin_bit_cast(float, b << 16); }
__device__ __forceinline__ unsigned pk2(float lo, float hi) { return f2bf(lo) | (f2bf(hi) << 16); }
__device__ __forceinline__ float wave_sum(float v) {
#pragma unroll
    for (int o = 1; o < 64; o <<= 1) v += __shfl_xor(v, o);
    return v;
}
__device__ __forceinline__ float sigmoidf_(float x) { return 1.0f / (1.0f + __expf(-x)); }
__device__ __forceinline__ float siluf_(float x) { return x / (1.0f + __expf(-x)); }

#define XB_TMO      128
#define XB_XCNT(j)  (256  + 64 * (j))
#define XB_XSUB(j)  (1280 + 64 * (j))
#define XB_XGEN(j)  (2304 + 64 * (j))
#define XB_TOP      3328
#define XB_TOPGEN   3392
#define XCD_BAR_WORDS 3456
#define XB_SPIN_CAP (1u << 18)
__device__ __forceinline__ unsigned xb_ld(unsigned* p)              { return __hip_atomic_load(p, __ATOMIC_RELAXED, __HIP_MEMORY_SCOPE_AGENT); }
__device__ __forceinline__ unsigned xb_add(unsigned* p, unsigned v) { return __hip_atomic_fetch_add(p, v, __ATOMIC_RELAXED, __HIP_MEMORY_SCOPE_AGENT); }
__device__ __forceinline__ unsigned xb_xcc_id() { return (unsigned)__builtin_amdgcn_s_getreg((3 << 11) | 20) & 0xFu; }
#define XB_SPIN(cond, bar) do { unsigned _sp = 0; while (cond) { __builtin_amdgcn_s_sleep(1); \
    if ((++_sp & 255u) == 0u) { if (xb_ld(&(bar)[XB_TMO])) break; if (_sp > XB_SPIN_CAP) { atomicAdd(&(bar)[XB_TMO], 1u); break; } } } } while (0)
struct XcdBarrier { unsigned* bar; unsigned x; volatile LAS unsigned* st; };
__device__ __forceinline__ XcdBarrier xcd_barrier_post(unsigned* bar, volatile LAS unsigned* st) {
    XcdBarrier b; b.bar = bar; b.x = xb_xcc_id(); b.st = st;
    if (threadIdx.x == 0) (void)xb_add(&bar[XB_XCNT(b.x)], 1u);
    return b;
}
__device__ __forceinline__ void xcd_barrier_complete(unsigned* bar, unsigned x, unsigned& nloc, unsigned& nx) {
    const unsigned G = gridDim.x * gridDim.y * gridDim.z;
    unsigned sum, cnt, mine, sp = 0u;
    for (;;) {
        sum = 0u; cnt = 0u; mine = 0u;
#pragma unroll
        for (unsigned j = 0; j < 16; ++j) { const unsigned c = xb_ld(&bar[XB_XCNT(j)]); sum += c; cnt += (c > 0u) ? 1u : 0u; mine = (j == x) ? c : mine; }
        if (sum == G) break;
        __builtin_amdgcn_s_sleep(1);
        if ((++sp & 255u) == 0u) { if (xb_ld(&bar[XB_TMO])) break; if (sp > XB_SPIN_CAP) { atomicAdd(&bar[XB_TMO], 1u); break; } }
    }
    nloc = mine > 0u ? mine : 1u; nx = cnt > 0u ? cnt : 1u;
}
__device__ __forceinline__ void xcd_barrier(const XcdBarrier& b) {
    asm volatile("s_waitcnt vmcnt(0)" ::: "memory");
    __syncthreads();
    if (threadIdx.x == 0) {
        unsigned* bar = b.bar;
        __builtin_amdgcn_s_waitcnt(0);
        unsigned nloc = b.st[0], nx = b.st[1];
        if (nloc == 0u) { xcd_barrier_complete(bar, b.x, nloc, nx); b.st[0] = nloc; b.st[1] = nx; }
        const unsigned old = xb_add(&bar[XB_XSUB(b.x)], 1u);
        const unsigned gen = old / nloc;
        if (old + 1u == (gen + 1u) * nloc) {
            __builtin_amdgcn_fence(__ATOMIC_RELEASE, "agent");
            asm volatile("s_waitcnt vmcnt(0)" ::: "memory");
            const unsigned og = xb_add(&bar[XB_TOP], 1u);
            const unsigned tg = og / nx;
            if (og + 1u == (tg + 1u) * nx) xb_add(&bar[XB_TOPGEN], 1u);
            else XB_SPIN(xb_ld(&bar[XB_TOPGEN]) == tg, bar);
            __builtin_amdgcn_fence(__ATOMIC_ACQUIRE, "agent");
            xb_add(&bar[XB_XGEN(b.x)], 1u);
            asm volatile("s_waitcnt vmcnt(0)" ::: "memory");
        } else {
            XB_SPIN(xb_ld(&bar[XB_XGEN(b.x)]) == gen, bar);
            __builtin_amdgcn_fence(__ATOMIC_ACQUIRE, "agent");
            asm volatile("s_waitcnt vmcnt(0)" ::: "memory");
        }
    }
    __syncthreads();
}

struct Ctx {
    LAS unsigned char* lds; unsigned char* ws;
    int tid, lane, wave, bid, G;
};
#define WSP(T, off) ((T*)(c.ws + (off)))

__device__ __forceinline__ void ph_prologue(const Ctx& c, const Args& a) {
    LAS float* W = (LAS float*)c.lds;
    const float* win = a.in[1];
    for (int i = c.tid; i < 1024 * 16; i += 512) { const int k = i >> 4, j = i & 15; W[k * 20 + j] = win[(size_t)k * INW + 4096 + j]; }
    __syncthreads();
    const float* x = a.in[0]; bf16* xb = WSP(bf16, O_XB); float* ab = WSP(float, O_AB);
    for (int row = c.bid * 8 + c.wave; row < NT; row += c.G * 8) {
        float acc[16];
#pragma unroll
        for (int n = 0; n < 16; ++n) acc[n] = 0.f;
#pragma unroll 1
        for (int j = 0; j < 4; ++j) {
            const f32x4 v = ((const f32x4*)(x + (size_t)row * D))[c.lane + 64 * j];
            u32x2 w2; w2.x = pk2(v.x, v.y); w2.y = pk2(v.z, v.w); ((u32x2*)(xb + (size_t)row * D))[c.lane + 64 * j] = w2;
#pragma unroll
            for (int i = 0; i < 4; ++i) {
                const int k = 4 * c.lane + 256 * j + i; const float xv = v[i];
#pragma unroll
                for (int q = 0; q < 4; ++q) { const f32x4 w = *(const LAS f32x4*)(W + k * 20 + 4 * q);
                    acc[4 * q + 0] += xv * w.x; acc[4 * q + 1] += xv * w.y; acc[4 * q + 2] += xv * w.z; acc[4 * q + 3] += xv * w.w; }
            }
        }
        float r = 0.f;
#pragma unroll
        for (int n = 0; n < 16; ++n) { const float s = wave_sum(acc[n]); r = (c.lane == n) ? s : r; }
        if (c.lane < 16) ab[(size_t)row * 16 + c.lane] = r;
    }
}

template <class AF, class BF, class EF>
__device__ __forceinline__ void gg_tile(const Ctx& c, int K, const AF& afn, const BF& bfn, const EF& efn) {
    LAS float* As = (LAS float*)c.lds;
    LAS float* Bs = As + 16 * 132;
    const int ty = c.tid >> 4, tx = c.tid & 15;
    const int ar = c.tid >> 2, ak = (c.tid & 3) * 4, bk = c.tid >> 5, bq = c.tid & 31;
    float acc[4][8];
#pragma unroll
    for (int i = 0; i < 4; ++i)
#pragma unroll
        for (int j = 0; j < 8; ++j) acc[i][j] = 0.f;
    for (int k0 = 0; k0 < K; k0 += 16) {
        const f32x4 av = afn(ar, k0 + ak);
        const f32x4 bv = bfn(k0 + bk, bq);
        __syncthreads();
        As[(ak + 0) * 132 + ar] = av.x; As[(ak + 1) * 132 + ar] = av.y; As[(ak + 2) * 132 + ar] = av.z; As[(ak + 3) * 132 + ar] = av.w;
        *(LAS f32x4*)(Bs + bk * 128 + bq * 4) = bv;
        __syncthreads();
#pragma unroll 4
        for (int kk = 0; kk < 16; ++kk) {
            const f32x4 a4 = *(const LAS f32x4*)(As + kk * 132 + ty * 4);
            const f32x4 b0 = *(const LAS f32x4*)(Bs + kk * 128 + tx * 8), b1 = *(const LAS f32x4*)(Bs + kk * 128 + tx * 8 + 4);
#pragma unroll
            for (int i = 0; i < 4; ++i) {
                acc[i][0] += a4[i] * b0.x; acc[i][1] += a4[i] * b0.y; acc[i][2] += a4[i] * b0.z; acc[i][3] += a4[i] * b0.w;
                acc[i][4] += a4[i] * b1.x; acc[i][5] += a4[i] * b1.y; acc[i][6] += a4[i] * b1.z; acc[i][7] += a4[i] * b1.w;
            }
        }
    }
#pragma unroll
    for (int i = 0; i < 4; ++i) efn(ty * 4 + i, tx * 8, acc[i]);
}
__device__ __forceinline__ f32x4 ld_bf16x4(const bf16* p) { const u32x2 w = *(const u32x2*)p; return (f32x4){bf2f(w.x & 0xffffu), bf2f(w.x >> 16), bf2f(w.y & 0xffffu), bf2f(w.y >> 16)}; }
struct ALin { const bf16* base; int lda; __device__ __forceinline__ f32x4 operator()(int r, int k) const { return ld_bf16x4(base + (size_t)r * lda + k); } };
struct AGather { const bf16* base; int lda; const LAS int* rows; __device__ __forceinline__ f32x4 operator()(int r, int k) const { return ld_bf16x4(base + (size_t)rows[r] * lda + k); } };
struct BPlain { const float* B; int ldb; __device__ __forceinline__ f32x4 operator()(int k, int q) const { return *(const f32x4*)(B + (size_t)k * ldb + 4 * q); } };
struct BGateUp { const float* B; int ldb; int up_off; __device__ __forceinline__ f32x4 operator()(int k, int q) const {
    const f32x2 g = *(const f32x2*)(B + (size_t)k * ldb + 2 * q), u = *(const f32x2*)(B + (size_t)k * ldb + up_off + 2 * q); return (f32x4){g.x, u.x, g.y, u.y}; } };
struct EBf16 { bf16* C; int ldc; float scale; __device__ __forceinline__ void operator()(int r, int cb, const float (&v)[8]) const {
    u32x4 w; w.x = pk2(v[0] * scale, v[1] * scale); w.y = pk2(v[2] * scale, v[3] * scale); w.z = pk2(v[4] * scale, v[5] * scale); w.w = pk2(v[6] * scale, v[7] * scale);
    *(u32x4*)(C + (size_t)r * ldc + cb) = w; } };
struct EBf16T { bf16* C; int ldc; __device__ __forceinline__ void operator()(int r, int cb, const float (&v)[8]) const {
#pragma unroll
    for (int j = 0; j < 8; ++j) C[(size_t)(cb + j) * ldc + r] = (bf16)f2bf(v[j]); } };
struct EF32 { float* C; int ldc; __device__ __forceinline__ void operator()(int r, int cb, const float (&v)[8]) const {
    *(f32x4*)(C + (size_t)r * ldc + cb) = (f32x4){v[0], v[1], v[2], v[3]}; *(f32x4*)(C + (size_t)r * ldc + cb + 4) = (f32x4){v[4], v[5], v[6], v[7]}; } };
struct ESwiglu { bf16* H; int ldh; __device__ __forceinline__ void operator()(int r, int cb, const float (&v)[8]) const {
    u32x2 w; w.x = pk2(siluf_(v[0]) * v[1], siluf_(v[2]) * v[3]); w.y = pk2(siluf_(v[4]) * v[5], siluf_(v[6]) * v[7]);
    *(u32x2*)(H + (size_t)r * ldh + (cb >> 1)) = w; } };

__device__ __forceinline__ void cvt_item(const float* W, int ldw, int K, int N, bf16* WT, LAS float* scr, int item, int lane) {
    const int nblk = N >> 5, kb = item / nblk, nb = item - kb * nblk, k0 = 64 * kb, n0 = 32 * nb;
#pragma unroll 8
    for (int i = 0; i < 32; ++i) { const int kk = 2 * i + (lane >> 5); scr[kk * 33 + (lane & 31)] = W[(size_t)(k0 + kk) * ldw + n0 + (lane & 31)]; }
    asm volatile("s_waitcnt lgkmcnt(0)" ::: "memory");
    const int cc = lane & 7;
#pragma unroll
    for (int j = 0; j < 4; ++j) { const int n = (lane >> 3) + 8 * j; const LAS float* sp = scr + (8 * cc) * 33 + n;
        u32x4 o; o.x = pk2(sp[0 * 33], sp[1 * 33]); o.y = pk2(sp[2 * 33], sp[3 * 33]); o.z = pk2(sp[4 * 33], sp[5 * 33]); o.w = pk2(sp[6 * 33], sp[7 * 33]);
        *(u32x4*)(WT + (size_t)(n0 + n) * K + k0 + 8 * cc) = o; }
    asm volatile("s_waitcnt lgkmcnt(0)" ::: "memory");
}
__device__ __forceinline__ void cvt_range(const Ctx& c, int gw, int NGW, const float* W, int ldw, int K, int N, int nmat, size_t sstride, bf16* WT, size_t dstride) {
    LAS float* scr = (LAS float*)(c.lds + c.wave * 8704);
    const int per = (K >> 6) * (N >> 5), total = per * nmat;
    for (int it = gw; it < total; it += NGW) { const int mi = it / per, r = it - mi * per; cvt_item(W + (size_t)mi * sstride, ldw, K, N, WT + (size_t)mi * dstride, scr, r, c.lane); }
}
__device__ __forceinline__ void cvt_small_weights(const Ctx& c, const Args& a, int gw, int NGW) {
    cvt_range(c, gw, NGW, a.in[1], INW, D, 4096, 1, 0, WSP(bf16, O_WIN), 0);
    cvt_range(c, gw, NGW, a.in[6], D, D, D, 1, 0, WSP(bf16, O_WOA), 0);
    cvt_range(c, gw, NGW, a.in[8], D, D, D, 1, 0, WSP(bf16, O_WQK), 0);
    cvt_range(c, gw, NGW, a.in[7], 2048, D, D, 1, 0, WSP(bf16, O_WQK) + (size_t)D * D, 0);
    cvt_range(c, gw, NGW, a.in[7] + 1024, 2048, D, D, 1, 0, WSP(bf16, O_WV), 0);
    cvt_range(c, gw, NGW, a.in[10], D, D, D, 1, 0, WSP(bf16, O_WOB), 0);
    cvt_range(c, gw, NGW, a.in[11], NE, D, NE, 2, (size_t)D * NE, WSP(bf16, O_WRS), (size_t)768 * D);
    cvt_range(c, gw, NGW, a.in[15], 512, D, 512, 2, (size_t)D * 512, WSP(bf16, O_WRS) + (size_t)256 * D, (size_t)768 * D);
    cvt_range(c, gw, NGW, a.in[16], D, DE, D, 2, (size_t)DE * D, WSP(bf16, O_WSD), (size_t)D * DE);
}
__device__ __forceinline__ void cvt_expert_weights(const Ctx& c, const Args& a, int gw, int NGW, int layer) {
    cvt_range(c, gw, NGW, a.in[13] + (size_t)layer * NE * D * 512, 512, D, 512, NE, (size_t)D * 512, WSP(bf16, O_WGU) + (size_t)layer * NE * 512 * D, (size_t)512 * D);
    cvt_range(c, gw, NGW, a.in[14] + (size_t)layer * NE * DE * D, D, DE, D, NE, (size_t)DE * D, WSP(bf16, O_WD) + (size_t)layer * NE * D * DE, (size_t)D * DE);
}

namespace pg8 {
typedef short bf16x8 __attribute__((ext_vector_type(8)));
constexpr int BM = 256, BK = 64, HALF = 128, HTB = HALF * BK * 2, STAGE_BYTES = 8 * HTB, NXCD = 8, WGM = 8;
__device__ __forceinline__ int lds_byte(int r, int c) { const int st = (r >> 4) * 2 + (c >> 5), rr = r & 15, cc = c & 31, ob = rr * 64 + cc * 2; return st * 1024 + (ob ^ (((ob >> 9) & 1) << 5)); }
__device__ __forceinline__ void stage_rc(int b, int& R, int& C) { const int st = b / 1024, sb = b % 1024, swz = sb ^ (((sb >> 9) & 1) << 5); R = (st >> 1) * 16 + swz / 64; C = (st & 1) * 32 + (swz % 64) / 2; }
__device__ __forceinline__ int perm32(int rho) { const int n = rho >> 4, i = rho & 15; return 8 * (i >> 2) + 4 * n + (i & 3); }
__device__ __forceinline__ unsigned cvt_pk_bf16(float lo, float hi) { unsigned r; asm volatile("v_cvt_pk_bf16_f32 %0, %1, %2" : "=v"(r) : "v"(lo), "v"(hi)); return r; }

struct GUnit {
    const char* A;
    const char* B;
    unsigned bh;
    int arow;
    int rl;
    char* optr; int ldc; int aux; float scale;
};
struct TileOrder {
    int nM, nN, nwg, G, c;
    __device__ __forceinline__ void init(int nM_, int nN_, int G_, int c_) { nM = nM_; nN = nN_; nwg = nM * nN; G = G_; c = c_; }
    __device__ __forceinline__ bool tile(int i, int& pm, int& pn) const { const long L = (long)i * G + c; if (L >= nwg) return false; at((int)L, pm, pn); return true; }
    __device__ __forceinline__ void at(int L, int& pm, int& pn) const {
        int wgid = L; { const int q = nwg / NXCD, r = nwg % NXCD, xcd = wgid % NXCD, off = wgid / NXCD; wgid = (xcd < r ? xcd * (q + 1) : r * (q + 1) + (xcd - r) * q) + off; }
        const int nig = WGM * nN, gid = wgid / nig, fm = gid * WGM, gsz = (nM - fm) < WGM ? (nM - fm) : WGM;
        pm = fm + ((wgid % nig) % gsz); pn = (wgid % nig) / gsz;
    }
};
template <class Epi, class Sched>
__device__ __forceinline__ void gemm_run(const int tid, LAS unsigned char* lds, const LAS int* rows, const int K, const Sched& S, const Epi& E) {
    const int wid = __builtin_amdgcn_readfirstlane(tid >> 6), lane = tid & 63, wr = wid >> 2, wc = wid & 3, fr = lane & 15, fq = lane >> 4;
    const int nt = K / BK;
    int R[2], C[2]; unsigned voffB[2];
#pragma unroll
    for (int i = 0; i < 2; ++i) { stage_rc(tid * 16 + i * 8192, R[i], C[i]); const int Rb = (R[i] & ~31) + perm32(R[i] & 31); voffB[i] = (unsigned)(Rb * K + C[i]) * 2u; }
    const size_t kstep = (size_t)(BK * 2);
    const unsigned ldsw = (unsigned)wid * 1024u;
    const int aoff = lds_byte(wr * 64 + fr, fq * 8), boff = lds_byte(wc * 32 + fr, fq * 8);
#define PG8_SA(b, h) (((b) * 2 + (h)) * HTB)
#define PG8_SB(b, h) ((4 + (b) * 2 + (h)) * HTB)
#define PG8_STAGE(bufoff, gbase, voff) do { _Pragma("unroll") for (int _i = 0; _i < 2; ++_i) \
        __builtin_amdgcn_global_load_lds((const unsigned*)((const char*)(gbase) + (voff)[_i]), (LAS unsigned*)(lds + (bufoff) + ldsw + _i * 8192), 16, 0, 0); } while (0)
#define PG8_LDA(dst, b, h) do { _Pragma("unroll") for (int m = 0; m < 4; ++m) _Pragma("unroll") for (int k = 0; k < 2; ++k) dst[m][k] = *(const LAS bf16x8*)(lds + PG8_SA(b, h) + aoff + m * 2048 + k * 1024); } while (0)
#define PG8_LDB(dst, b, h) do { _Pragma("unroll") for (int n = 0; n < 2; ++n) _Pragma("unroll") for (int k = 0; k < 2; ++k) dst[n][k] = *(const LAS bf16x8*)(lds + PG8_SB(b, h) + boff + n * 2048 + k * 1024); } while (0)
#define PG8_MMA(ai, bj, At, Bt) do { __builtin_amdgcn_s_setprio(1); _Pragma("unroll") for (int m = 0; m < 4; ++m) _Pragma("unroll") for (int n = 0; n < 2; ++n) _Pragma("unroll") for (int k = 0; k < 2; ++k) \
        acc[ai][bj][m][n] = __builtin_amdgcn_mfma_f32_16x16x32_bf16(Bt[n][k], At[m][k], acc[ai][bj][m][n], 0, 0, 0); __builtin_amdgcn_s_setprio(0); } while (0)
#define PG8_WAIT_V(n) asm volatile("s_waitcnt vmcnt(" #n ")" ::: "memory")
#define PG8_WAIT_L(n) asm volatile("s_waitcnt lgkmcnt(" #n ")" ::: "memory")
#define PG8_BAR __builtin_amdgcn_s_barrier()
#define PG8_SCHED __builtin_amdgcn_sched_barrier(0)
#define PG8_AOFF(u, dst) do { _Pragma("unroll") for (int _h = 0; _h < 2; ++_h) _Pragma("unroll") for (int _i = 0; _i < 2; ++_i) { const int _r = _h * HALF + R[_i]; \
        const int _row = (u).arow >= 0 ? (u).arow + _r : rows[(u).rl + _r]; dst[_h][_i] = (unsigned)(_row * K + C[_i]) * 2u; } } while (0)
    GUnit cur, nxt; int ui = 0;
    if (!S.next(0, cur)) return;
    f32x4 acc[2][2][4][2];
#pragma unroll
    for (int a = 0; a < 2; ++a)
#pragma unroll
        for (int b = 0; b < 2; ++b)
#pragma unroll
            for (int m = 0; m < 4; ++m)
#pragma unroll
                for (int n = 0; n < 2; ++n) acc[a][b][m][n] = (f32x4){0.f, 0.f, 0.f, 0.f};
    bf16x8 At[4][2], B0[2][2], B1[2][2];
    unsigned cO[2][2], nO[2][2];
    PG8_AOFF(cur, cO);
    const char* cA = cur.A; const char* cB = cur.B; unsigned cbh = cur.bh;
    PG8_STAGE(PG8_SB(0, 0), cB, voffB); PG8_STAGE(PG8_SB(0, 1), cB + cbh, voffB); PG8_STAGE(PG8_SA(0, 0), cA, cO[0]); PG8_STAGE(PG8_SA(0, 1), cA, cO[1]);
    if (wr == 1) PG8_BAR;
    PG8_WAIT_V(2); PG8_BAR;
    PG8_STAGE(PG8_SB(1, 0), cB + kstep, voffB); PG8_STAGE(PG8_SA(1, 0), cA + kstep, cO[0]); PG8_STAGE(PG8_SB(1, 1), cB + cbh + kstep, voffB);
    PG8_WAIT_V(6); PG8_BAR;
    for (;;) {
        const bool has_next = S.next(ui + 1, nxt);
        const char* nA = cA; const char* nB = cB; unsigned nbh = cbh;
#pragma unroll
        for (int h = 0; h < 2; ++h)
#pragma unroll
            for (int i = 0; i < 2; ++i) nO[h][i] = cO[h][i];
        if (has_next) { nA = nxt.A; nB = nxt.B; nbh = nxt.bh; PG8_AOFF(nxt, nO); }
        for (int t = 0; t < nt; t += 2) {
            const bool last = (t == nt - 2);
            const char* a1 = cA + (size_t)(t + 1) * kstep;
            const char* a2 = last ? nA : cA + (size_t)(t + 2) * kstep; const char* b2 = last ? nB : cB + (size_t)(t + 2) * kstep;
            const unsigned bh2 = last ? nbh : cbh;
            unsigned o2[2][2];
#pragma unroll
            for (int h = 0; h < 2; ++h)
#pragma unroll
                for (int i = 0; i < 2; ++i) o2[h][i] = last ? nO[h][i] : cO[h][i];
            const char* a3 = a2 + kstep; const char* b3 = b2 + kstep;
            PG8_LDB(B0, 0, 0); PG8_LDB(B1, 0, 1); PG8_SCHED; PG8_LDA(At, 0, 0); PG8_STAGE(PG8_SA(1, 1), a1, cO[1]);
            PG8_WAIT_V(8); PG8_WAIT_L(0); PG8_BAR; PG8_MMA(0, 0, At, B0); PG8_MMA(0, 1, At, B1); PG8_BAR; PG8_SCHED;
            PG8_LDA(At, 0, 1); PG8_STAGE(PG8_SB(0, 0), b2, voffB); PG8_STAGE(PG8_SB(0, 1), b2 + bh2, voffB); PG8_STAGE(PG8_SA(0, 0), a2, o2[0]);
            PG8_WAIT_V(8); PG8_WAIT_L(0); PG8_BAR; PG8_MMA(1, 0, At, B0); PG8_MMA(1, 1, At, B1); PG8_BAR; PG8_SCHED;
            PG8_LDB(B0, 1, 0); PG8_LDB(B1, 1, 1); PG8_SCHED; PG8_LDA(At, 1, 0); PG8_STAGE(PG8_SA(0, 1), a2, o2[1]);
            PG8_WAIT_V(8); PG8_WAIT_L(0); PG8_BAR; PG8_MMA(0, 0, At, B0); PG8_MMA(0, 1, At, B1); PG8_BAR; PG8_SCHED;
            PG8_LDA(At, 1, 1); PG8_STAGE(PG8_SB(1, 0), b3, voffB); PG8_STAGE(PG8_SB(1, 1), b3 + bh2, voffB); PG8_STAGE(PG8_SA(1, 0), a3, o2[0]);
            PG8_WAIT_V(8); PG8_WAIT_L(0); PG8_BAR; PG8_MMA(1, 0, At, B0); PG8_MMA(1, 1, At, B1); PG8_BAR; PG8_SCHED;
        }
        if (wr == 0) PG8_BAR;
        E(acc, cur, wr, wc, fr, fq);
        if (!has_next) break;
#pragma unroll
        for (int a = 0; a < 2; ++a)
#pragma unroll
            for (int b = 0; b < 2; ++b)
#pragma unroll
                for (int m = 0; m < 4; ++m)
#pragma unroll
                    for (int n = 0; n < 2; ++n) acc[a][b][m][n] = (f32x4){0.f, 0.f, 0.f, 0.f};
        cur = nxt; cA = nA; cB = nB; cbh = nbh; ++ui;
#pragma unroll
        for (int h = 0; h < 2; ++h)
#pragma unroll
            for (int i = 0; i < 2; ++i) cO[h][i] = nO[h][i];
        if (wr == 1) PG8_BAR;
    }
    PG8_WAIT_V(0);
    PG8_BAR;
#undef PG8_SA
#undef PG8_SB
#undef PG8_STAGE
#undef PG8_LDA
#undef PG8_LDB
#undef PG8_MMA
#undef PG8_WAIT_V
#undef PG8_WAIT_L
#undef PG8_BAR
#undef PG8_SCHED
#undef PG8_AOFF
}
struct EpiBf16 {
    __device__ __forceinline__ void operator()(const f32x4 (&acc)[2][2][4][2], const GUnit& u, int wr, int wc, int fr, int fq) const {
        bf16* base = (bf16*)u.optr + (size_t)(wr * 64 + fr) * u.ldc + wc * 32 + 8 * fq; const float sc = u.scale;
#pragma unroll
        for (int ai = 0; ai < 2; ++ai)
#pragma unroll
            for (int m = 0; m < 4; ++m) { bf16* rowp = base + (size_t)(ai * HALF + m * 16) * u.ldc;
#pragma unroll
                for (int bj = 0; bj < 2; ++bj) { const f32x4 v0 = acc[ai][bj][m][0] * sc, v1 = acc[ai][bj][m][1] * sc;
                    u32x4 w; w.x = cvt_pk_bf16(v0[0], v0[1]); w.y = cvt_pk_bf16(v0[2], v0[3]); w.z = cvt_pk_bf16(v1[0], v1[1]); w.w = cvt_pk_bf16(v1[2], v1[3]);
                    *(u32x4*)(rowp + bj * HALF) = w; } }
    }
};
struct DenseSched {
    TileOrder T; const bf16* A; const bf16* Bt; int K; bf16* O; int ldc; float scale;
    __device__ __forceinline__ bool next(int i, GUnit& u) const {
        int pm, pn; if (!T.tile(i, pm, pn)) return false;
        u.A = (const char*)A; u.B = (const char*)(Bt + (size_t)pn * BM * K); u.bh = (unsigned)(HALF * K * 2); u.arow = pm * BM; u.rl = 0;
        u.optr = (char*)(O + (size_t)pm * BM * ldc + pn * BM); u.ldc = ldc; u.aux = 0; u.scale = scale; return true;
    }
};
struct QkvSched {
    TileOrder T1, T2; int G, c; const bf16 *XB, *WQK, *WV; bf16 *Q, *Kb, *VT;
    __device__ __forceinline__ bool next(int i, GUnit& u) const {
        const int L = i * G + c; if (L >= 1536) return false;
        int pm, pn; u.bh = (unsigned)(HALF * D * 2); u.rl = 0; u.aux = 0;
        if (L < 1024) { T1.at(L, pm, pn); u.A = (const char*)XB; u.B = (const char*)(WQK + (size_t)pn * BM * D); u.arow = pm * BM; u.ldc = D;
            if (pn < 4) { u.optr = (char*)(Q + (size_t)pm * BM * D + pn * BM); u.scale = 0.125f; } else { u.optr = (char*)(Kb + (size_t)pm * BM * D + (pn - 4) * BM); u.scale = 1.f; } }
        else { T2.at(L - 1024, pm, pn); u.A = (const char*)WV; u.B = (const char*)(XB + (size_t)pn * BM * D); u.arow = pm * BM; u.ldc = NT; u.optr = (char*)(VT + (size_t)pm * BM * NT + (size_t)pn * BM); u.scale = 1.f; }
        return true;
    }
};
struct EpiMoe {
    __device__ __forceinline__ void operator()(const f32x4 (&acc)[2][2][4][2], const GUnit& u, int wr, int wc, int fr, int fq) const {
        if (u.aux == 0) {
            bf16* base = (bf16*)u.optr + (size_t)(wr * 64 + fr) * u.ldc + wc * 32 + 8 * fq;
#pragma unroll
            for (int ai = 0; ai < 2; ++ai)
#pragma unroll
                for (int m = 0; m < 4; ++m) { float hv[8];
#pragma unroll
                    for (int n = 0; n < 2; ++n)
#pragma unroll
                        for (int j = 0; j < 4; ++j) { const float g = acc[ai][0][m][n][j], up = acc[ai][1][m][n][j]; hv[4 * n + j] = g * __builtin_amdgcn_rcpf(1.0f + __expf(-g)) * up; }
                    u32x4 w; w.x = cvt_pk_bf16(hv[0], hv[1]); w.y = cvt_pk_bf16(hv[2], hv[3]); w.z = cvt_pk_bf16(hv[4], hv[5]); w.w = cvt_pk_bf16(hv[6], hv[7]);
                    *(u32x4*)(base + (size_t)(ai * HALF + m * 16) * u.ldc) = w; }
        } else {
            float* base = (float*)u.optr + (size_t)(wr * 64 + fr) * u.ldc + wc * 32 + 8 * fq;
#pragma unroll
            for (int ai = 0; ai < 2; ++ai)
#pragma unroll
                for (int m = 0; m < 4; ++m) { float* rowp = base + (size_t)(ai * HALF + m * 16) * u.ldc;
#pragma unroll
                    for (int bj = 0; bj < 2; ++bj) { *(f32x4*)(rowp + bj * HALF) = acc[ai][bj][m][0]; *(f32x4*)(rowp + bj * HALF + 4) = acc[ai][bj][m][1]; } }
        }
    }
};
struct RouterSharedSched {
    int G, c; const bf16 *XB, *WRS; float* logits; bf16* H;
    __device__ __forceinline__ bool next(int i, GUnit& u) const {
        const int L = i * G + c; if (L >= 384) return false;
        u.A = (const char*)XB; u.rl = 0; u.scale = 1.f;
        if (L < 256) { const int pm = L >> 1, nh = L & 1; u.arow = pm * BM; u.B = (const char*)(WRS + (size_t)(256 + nh * HALF) * D); u.bh = (unsigned)(256 * D * 2);
            u.optr = (char*)(H + (size_t)(SH0 + pm * BM) * DE + nh * HALF); u.ldc = DE; u.aux = 0; }
        else { const int pm = L - 256; u.arow = pm * BM; u.B = (const char*)WRS; u.bh = (unsigned)(HALF * D * 2); u.optr = (char*)(logits + (size_t)pm * BM * NE); u.ldc = NE; u.aux = 1; }
        return true;
    }
};
struct MoeGuSched {
    int G, vc, ntile; const LAS int* ts; const bf16 *XB, *WGU; bf16* H;
    __device__ __forceinline__ bool next(int i, GUnit& u) const {
        const int L = i * G + vc; if (L >= 2 * ntile) return false;
        const int mt = L >> 1, nh = L & 1; int lo = 0, hi = 255; while (lo < hi) { const int mid = (lo + hi + 1) >> 1; if (ts[mid] <= mt) lo = mid; else hi = mid - 1; }
        const int e = __builtin_amdgcn_readfirstlane(lo);
        u.A = (const char*)XB; u.arow = -1; u.rl = i * BM; u.B = (const char*)(WGU + ((size_t)e * 512 + nh * HALF) * D); u.bh = (unsigned)(256 * D * 2);
        u.optr = (char*)(H + (size_t)mt * BM * DE + nh * HALF); u.ldc = DE; u.aux = 0; u.scale = 1.f; return true;
    }
};
struct MoeDownSched {
    int G, vc, ntile; const LAS int* ts; const bf16 *H, *WD, *WSD; bf16* Y;
    __device__ __forceinline__ bool next(int i, GUnit& u) const {
        const int L = i * G + vc; if (L >= 4 * (ntile + NT / BM)) return false;
        const int mt = L >> 2, pn = L & 3; u.A = (const char*)H; u.rl = 0; u.bh = (unsigned)(HALF * DE * 2); u.ldc = D; u.aux = 0; u.scale = 1.f;
        if (mt < ntile) { int lo = 0, hi = 255; while (lo < hi) { const int mid = (lo + hi + 1) >> 1; if (ts[mid] <= mt) lo = mid; else hi = mid - 1; }
            const int e = __builtin_amdgcn_readfirstlane(lo);
            u.arow = mt * BM; u.B = (const char*)(WD + ((size_t)e * D + pn * BM) * DE); u.optr = (char*)(Y + (size_t)mt * BM * D + pn * BM); }
        else { const int row0 = SH0 + (mt - ntile) * BM; u.arow = row0; u.B = (const char*)(WSD + (size_t)pn * BM * DE); u.optr = (char*)(Y + (size_t)row0 * D + pn * BM); }
        return true;
    }
};
}

__device__ __forceinline__ void ph_inproj_golden(const Ctx& c, const Args& a) {
    const bf16* xb = WSP(bf16, O_XB); bf16* proj = WSP(bf16, O_PROJ);
    for (int u = c.bid; u < (NT / 128) * 32; u += c.G) {
        const int mb = u >> 5, nb = u & 31;
        gg_tile(c, D, ALin{xb + (size_t)mb * 128 * D, D}, BPlain{a.in[1] + nb * 128, INW}, EBf16{proj + (size_t)mb * 128 * 4096 + nb * 128, 4096, 1.f});
    }
}

__device__ __forceinline__ void ph_inproj(const Ctx& c, const Args& a) {
    pg8::DenseSched S; S.T.init(NT / 256, 4096 / 256, c.G, c.bid); S.A = WSP(bf16, O_XB); S.Bt = WSP(bf16, O_WIN); S.K = D; S.O = WSP(bf16, O_PROJ); S.ldc = 4096; S.scale = 1.f;
    pg8::gemm_run(c.tid, c.lds, (const LAS int*)(c.lds + pg8::STAGE_BYTES), D, S, pg8::EpiBf16{});
}
__device__ __forceinline__ void ph_delta_golden(const Ctx& c, const Args& a) {
    LAS float* raw = (LAS float*)c.lds;
    LAS float* red = raw + 384;
    LAS float* red2 = red + 512;
    LAS float* nrm = red2 + 512;
    const bf16* proj = WSP(bf16, O_PROJ); const float* ab = WSP(float, O_AB); bf16* O = WSP(bf16, O_O);
    const float* convw = a.in[2];
    for (int bh = c.bid; bh < NB * DNH; bh += c.G) {
        const int b = bh / DNH, h = bh % DNH;
        const int e = c.tid & 127, part = c.tid >> 7;
        float S[32];
#pragma unroll
        for (int i = 0; i < 32; ++i) S[i] = 0.f;
        const int ch = c.tid;
        const int col = (ch >> 7) * 1024 + h * 128 + (ch & 127);
        float w0 = 0, w1 = 0, w2 = 0, w3 = 0, x0 = 0, x1 = 0, x2 = 0;
        if (ch < 384) { w0 = convw[0 * QKVW + col]; w1 = convw[1 * QKVW + col]; w2 = convw[2 * QKVW + col]; w3 = convw[3 * QKVW + col]; }
        const float Ah = __expf(a.in[3][h]), dtb = a.in[4][h];
        for (int t = 0; t < SEQ; ++t) {
            const size_t tok = (size_t)b * SEQ + t;
            if (ch < 384) { const float x3 = bf2f(proj[tok * 4096 + col]); const float y = x0 * w0 + x1 * w1 + x2 * w2 + x3 * w3; raw[ch] = siluf_(y); x0 = x1; x1 = x2; x2 = x3; }
            __syncthreads();
            if (c.wave < 2) { const float v0 = raw[c.wave * 128 + c.lane], v1 = raw[c.wave * 128 + 64 + c.lane]; const float s = wave_sum(v0 * v0 + v1 * v1); if (c.lane == 0) nrm[c.wave] = s; }
            __syncthreads();
            const float rq = rsqrtf(nrm[0] + NORM_EPS) * 0.08838834764831845f, rk = rsqrtf(nrm[1] + NORM_EPS);
            const float av = ab[tok * 16 + h], bv = ab[tok * 16 + 8 + h];
            const float xx = av + dtb; const float sp = xx > 20.f ? xx : log1pf(__expf(xx));
            const float dec = __expf(-Ah * sp), beta = sigmoidf_(bv);
            float r = 0.f;
#pragma unroll
            for (int i = 0; i < 32; ++i) { S[i] *= dec; r += raw[128 + part * 32 + i] * rk * S[i]; }
            red[part * 128 + e] = r;
            __syncthreads();
            const float rr = red[e] + red[128 + e] + red[256 + e] + red[384 + e];
            const float vnew = beta * (raw[256 + e] - rr);
            float o = 0.f;
#pragma unroll
            for (int i = 0; i < 32; ++i) { S[i] += raw[128 + part * 32 + i] * rk * vnew; o += raw[part * 32 + i] * rq * S[i]; }
            red2[part * 128 + e] = o;
            __syncthreads();
            if (part == 0) { const float oo = red2[e] + red2[128 + e] + red2[256 + e] + red2[384 + e]; O[tok * D + h * 128 + e] = (bf16)f2bf(oo); }
        }
        __syncthreads();
    }
}

__device__ __forceinline__ int perm16(int x) { return (((x >> 2) & 1) << 3) + ((x >> 3) << 2) + (x & 3); }
__device__ __forceinline__ void ph_delta_d1(const Ctx& c, const Args& a) {
    constexpr int LD = 129;
    LAS float* qs = (LAS float*)c.lds;
    LAS float* ks = qs + 64 * LD;
    LAS float* vs = ks + 64 * LD;
    LAS float* At = vs + 64 * LD;
    LAS float* Tm = At + 64 * 65;
    LAS float* Xm = Tm + 64 * 65;
    LAS float* gcs = Xm + 32 * 33;
    LAS float* bts = gcs + 64;
    LAS float* rn = bts + 64;
    const bf16* proj = WSP(bf16, O_PROJ); const float* ab = WSP(float, O_AB); const float* convw = a.in[2];
    for (int uid = c.bid; uid < NUNIT; uid += c.G) {
        const int n = uid % NCH, bh = uid / NCH, h = bh % DNH, b = bh / DNH;
        const size_t tok0 = (size_t)b * SEQ + n * CHUNK;
        unsigned char* blk = c.ws + O_DU + (size_t)uid * DU_BYTES;
        __syncthreads();
        int tid = c.tid, lane = c.lane; asm volatile("" : "+v"(tid), "+v"(lane));
        if (tid < 384) {
            const int quad = tid % 96, tb = tid / 96, ch0 = quad * 4, mat = ch0 >> 7, cc = ch0 & 127;
            const int col = mat * 1024 + h * 128 + cc;
            f32x4 w[4];
#pragma unroll
            for (int j = 0; j < 4; ++j) w[j] = *(const f32x4*)(convw + j * QKVW + col);
            f32x4 hist[3];
#pragma unroll
            for (int j = 0; j < 3; ++j) { const int t = n * CHUNK + tb * 16 - 3 + j; hist[j] = t >= 0 ? ld_bf16x4(proj + ((size_t)b * SEQ + t) * 4096 + col) : (f32x4){0.f, 0.f, 0.f, 0.f}; }
            LAS float* dst = (mat == 0 ? qs : (mat == 1 ? ks : vs));
#pragma unroll 2
            for (int t = 0; t < 16; ++t) {
                const f32x4 x = ld_bf16x4(proj + (tok0 + tb * 16 + t) * 4096 + col);
                const f32x4 y = hist[0] * w[0] + hist[1] * w[1] + hist[2] * w[2] + x * w[3];
                hist[0] = hist[1]; hist[1] = hist[2]; hist[2] = x;
                LAS float* d = dst + (tb * 16 + t) * LD + cc;
                d[0] = siluf_(y.x); d[1] = siluf_(y.y); d[2] = siluf_(y.z); d[3] = siluf_(y.w);
            }
        }
        if (c.wave == 7) {
            const float av = ab[(tok0 + lane) * 16 + h], bv = ab[(tok0 + lane) * 16 + 8 + h];
            const float xx = av + a.in[4][h]; const float sp = xx > 20.f ? xx : log1pf(__expf(xx));
            float g = -__expf(a.in[3][h]) * sp;
#pragma unroll
            for (int o = 1; o < 64; o <<= 1) { const float t = __shfl_up(g, o); if (lane >= o) g += t; }
            gcs[lane] = g; bts[lane] = sigmoidf_(bv);
        }
        __syncthreads();
        if (tid < 128) { const int m = tid >> 6, t = tid & 63; const LAS float* r = (m ? ks : qs) + t * LD; float sm = 0.f; for (int d = 0; d < 128; ++d) sm += r[d] * r[d];
            rn[m * 64 + t] = rsqrtf(sm + NORM_EPS) * (m ? 1.f : 0.08838834764831845f); }
        __syncthreads();
        for (int i = tid; i < 64 * 128; i += 512) { const int t = i >> 7, d = i & 127; qs[t * LD + d] *= rn[t]; ks[t * LD + d] *= rn[64 + t]; }
        __syncthreads();
        const float gl = gcs[63];
        if (tid == 0) WSP(float, O_EGL)[uid] = __expf(gl);
        {
            const int i = tid >> 3, jg = tid & 7; float kk[8], qk[8];
#pragma unroll
            for (int j = 0; j < 8; ++j) { kk[j] = 0.f; qk[j] = 0.f; }
            if (jg * 8 <= i)
#pragma unroll 2
            for (int d = 0; d < 128; ++d) { const float ki = ks[i * LD + d], qi = qs[i * LD + d];
#pragma unroll
                for (int j = 0; j < 8; ++j) { const float kj = ks[(jg * 8 + j) * LD + d]; kk[j] += ki * kj; qk[j] += qi * kj; } }
            const float gci = gcs[i], bi = bts[i]; unsigned short pv[8];
#pragma unroll
            for (int j = 0; j < 8; ++j) { const int jj = jg * 8 + j; const float dec = (jj <= i) ? __expf(gci - gcs[jj]) : 0.f;
                At[jj * 65 + i] = (jj < i) ? bi * kk[j] * dec : 0.f; pv[j] = (unsigned short)f2bf(qk[j] * dec); }
            bf16* P = (bf16*)(blk + DU_P) + i * 64;
#pragma unroll
            for (int j = 0; j < 8; ++j) P[(jg * 8 & ~15) + perm16((jg * 8 + j) & 15)] = pv[j];
        }
        __syncthreads();
        if (c.wave == 0) {
            const int o0 = (lane >> 5) * 32, ii = lane & 31; LAS float* Tr = Tm + lane * 65 + o0;
            if (o0 == 0) for (int j = 0; j < 32; ++j) Tm[lane * 65 + 32 + j] = 0.f;
#pragma unroll 1
            for (int j = 31; j >= 0; --j) { float sacc = (ii == j) ? 1.f : 0.f; const LAS float* Ar = At + (o0 + j) * 65 + o0;
#pragma unroll 1
                for (int k = j + 1; k < 32; ++k) sacc -= Tr[k] * Ar[k];
                Tr[j] = sacc; }
        }
        __syncthreads();
        for (int i = tid; i < 1024; i += 512) { const int r = i >> 5, cc = i & 31; float sm = 0.f; for (int k = 0; k < 32; ++k) sm += At[k * 65 + 32 + r] * Tm[k * 65 + cc]; Xm[r * 33 + cc] = sm; }
        __syncthreads();
        for (int i = tid; i < 1024; i += 512) { const int r = i >> 5, cc = i & 31; float sm = 0.f; for (int k = 0; k < 32; ++k) sm += Tm[(32 + r) * 65 + 32 + k] * Xm[k * 33 + cc]; Tm[(32 + r) * 65 + cc] = -sm; }
        __syncthreads();
        {
            const int i = tid >> 3, cg = tid & 7; float uu[16], ww[16];
#pragma unroll
            for (int q = 0; q < 16; ++q) { uu[q] = 0.f; ww[q] = 0.f; }
#pragma unroll 1
            for (int j = 0; j <= i; ++j) { const float t = Tm[i * 65 + j] * bts[j], te = t * __expf(gcs[j]);
#pragma unroll
                for (int q = 0; q < 16; ++q) { uu[q] += t * vs[j * LD + cg * 16 + q]; ww[q] += te * ks[j * LD + cg * 16 + q]; } }
            bf16* U = (bf16*)(blk + DU_U); bf16* NW = (bf16*)(blk + DU_NW) + i * 128 + cg * 16;
            const int rt = i >> 5, ri = i & 31, hh = (ri >> 2) & 1, rg = 4 * (ri >> 3) + (ri & 3), hf = rg >> 3;
#pragma unroll
            for (int q = 0; q < 16; ++q) { const int e = cg * 16 + q, sl = e >> 5, ln = (e & 31) + 32 * hh;
                U[((((sl * 2 + rt) * 2 + hf) * 64 + ln) * 8) + (rg & 7)] = (bf16)f2bf(uu[q]); NW[perm16(q)] = (bf16)f2bf(-ww[q]); }
        }
        for (int i = tid; i < 64 * 128; i += 512) { const int t = i >> 7, d = i & 127; ((bf16*)(blk + DU_QG))[t * 128 + (d & ~15) + perm16(d & 15)] = (bf16)f2bf(qs[t * LD + d] * __expf(gcs[t])); }
        for (int i = tid; i < 64 * 128; i += 512) { const int d = i >> 6, t = i & 63; ((bf16*)(blk + DU_KDT))[d * 64 + (t & ~15) + perm16(t & 15)] = (bf16)f2bf(ks[t * LD + d] * __expf(gl - gcs[t])); }
    }
}
typedef short bf16x8_t __attribute__((ext_vector_type(8)));
typedef float f32x16 __attribute__((ext_vector_type(16)));
__device__ __forceinline__ bf16x8_t pack8(const f32x16& x, int s) {
    u32x4 w;
    if (s == 0) { w.x = pg8::cvt_pk_bf16(x[0], x[1]); w.y = pg8::cvt_pk_bf16(x[2], x[3]); w.z = pg8::cvt_pk_bf16(x[4], x[5]); w.w = pg8::cvt_pk_bf16(x[6], x[7]); }
    else { w.x = pg8::cvt_pk_bf16(x[8], x[9]); w.y = pg8::cvt_pk_bf16(x[10], x[11]); w.z = pg8::cvt_pk_bf16(x[12], x[13]); w.w = pg8::cvt_pk_bf16(x[14], x[15]); }
    return __builtin_bit_cast(bf16x8_t, w);
}
__device__ __forceinline__ void d2_issue(const Ctx& c, const unsigned char* blk, LAS unsigned char* buf) {
#pragma unroll
    for (int k = 0; k < 9; ++k) {
        const int q = c.wave + 8 * k;
        const unsigned char* src;
        if (q < 32) { const int row = 4 * (q & 15) + (c.lane >> 4), slot = c.lane & 15, cp = slot ^ (row & 15); src = blk + (q >> 4) * 16384 + row * 256 + cp * 16; }
        else if (q < 56) { const int row = 8 * ((q - 32) & 15) + (c.lane >> 3), slot = c.lane & 7, cp = slot ^ (row & 7); src = blk + 32768 + ((q - 32) >> 4) * 16384 + row * 128 + cp * 16; }
        else src = blk + q * 1024 + c.lane * 16;
        __builtin_amdgcn_global_load_lds((const unsigned*)src, (LAS unsigned*)(buf + q * 1024), 16, 0, 0);
    }
}
__device__ __forceinline__ void ph_delta_d2(const Ctx& c) {
    constexpr int STG = 73728;
    if (c.bid >= NB * DNH) return;
    const int bh = c.bid, h = bh % DNH, b = bh / DNH, sl = c.wave, r = c.lane & 31, hh = c.lane >> 5;
    const unsigned char* blk0 = c.ws + O_DU + (size_t)bh * NCH * DU_BYTES;
    const float* egl = WSP(float, O_EGL) + bh * NCH;
    bf16* O = WSP(bf16, O_O);
    f32x16 S[4];
#pragma unroll
    for (int i = 0; i < 4; ++i)
#pragma unroll
        for (int j = 0; j < 16; ++j) S[i][j] = 0.f;
    d2_issue(c, blk0, c.lds);
    for (int n = 0; n < NCH; ++n) {
        LAS unsigned char* buf = c.lds + (n & 1) * STG;
        d2_issue(c, blk0 + (size_t)(n + 1 < NCH ? n + 1 : n) * DU_BYTES, c.lds + ((n + 1) & 1) * STG);
        asm volatile("s_waitcnt vmcnt(9)" ::: "memory");
        __builtin_amdgcn_s_barrier();
        asm volatile("" ::: "memory");
        if (sl < 4) {
            f32x16 av[2], ao[2];
#pragma unroll
            for (int rt = 0; rt < 2; ++rt)
#pragma unroll
                for (int hf = 0; hf < 2; ++hf) { const u32x4 t = *(const LAS u32x4*)(buf + DU_U + ((((sl * 2 + rt) * 2 + hf) * 64 + c.lane) << 4));
                    av[rt][8 * hf + 0] = bf2f(t.x & 0xffffu); av[rt][8 * hf + 1] = bf2f(t.x >> 16); av[rt][8 * hf + 2] = bf2f(t.y & 0xffffu); av[rt][8 * hf + 3] = bf2f(t.y >> 16);
                    av[rt][8 * hf + 4] = bf2f(t.z & 0xffffu); av[rt][8 * hf + 5] = bf2f(t.z >> 16); av[rt][8 * hf + 6] = bf2f(t.w & 0xffffu); av[rt][8 * hf + 7] = bf2f(t.w >> 16); }
#pragma unroll
            for (int j = 0; j < 16; ++j) { ao[0][j] = 0.f; ao[1][j] = 0.f; }
            const float eg = egl[n];
#pragma unroll
            for (int db = 0; db < 4; ++db) {
                bf16x8_t sb[2]; sb[0] = pack8(S[db], 0); sb[1] = pack8(S[db], 1);
#pragma unroll
                for (int rt = 0; rt < 2; ++rt)
#pragma unroll
                    for (int s = 0; s < 2; ++s) { const int row = 32 * rt + r, cp = 4 * db + 2 * s + hh; const int off = row * 256 + ((cp ^ (row & 15)) << 4);
                        const bf16x8_t aw = *(const LAS bf16x8_t*)(buf + off), aq = *(const LAS bf16x8_t*)(buf + 16384 + off);
                        av[rt] = __builtin_amdgcn_mfma_f32_32x32x16_bf16(aw, sb[s], av[rt], 0, 0, 0);
                        ao[rt] = __builtin_amdgcn_mfma_f32_32x32x16_bf16(aq, sb[s], ao[rt], 0, 0, 0); }
                asm volatile("" ::: "memory");
            }
            bf16x8_t vb[2][2];
#pragma unroll
            for (int jt = 0; jt < 2; ++jt) { vb[jt][0] = pack8(av[jt], 0); vb[jt][1] = pack8(av[jt], 1); }
#pragma unroll
            for (int rt = 0; rt < 2; ++rt)
#pragma unroll
                for (int jt = 0; jt <= rt; ++jt)
#pragma unroll
                    for (int s = 0; s < 2; ++s) { const int row = 32 * rt + r, cp = 4 * jt + 2 * s + hh; const bf16x8_t ap = *(const LAS bf16x8_t*)(buf + 49152 + row * 128 + ((cp ^ (row & 7)) << 4));
                        ao[rt] = __builtin_amdgcn_mfma_f32_32x32x16_bf16(ap, vb[jt][s], ao[rt], 0, 0, 0); }
            bf16* orow = O + ((size_t)b * SEQ + n * CHUNK) * D + h * 128 + sl * 32 + r;
#pragma unroll
            for (int rt = 0; rt < 2; ++rt)
#pragma unroll
                for (int j = 0; j < 16; ++j) { const int tkn = 32 * rt + (j & 3) + 8 * (j >> 2) + 4 * hh; orow[(size_t)tkn * D] = (bf16)f2bf(ao[rt][j]); }
#pragma unroll
            for (int db = 0; db < 4; ++db) {
#pragma unroll
                for (int j = 0; j < 16; ++j) S[db][j] *= eg;
#pragma unroll
                for (int jt = 0; jt < 2; ++jt)
#pragma unroll
                    for (int s = 0; s < 2; ++s) { const int row = 32 * db + r, cp = 4 * jt + 2 * s + hh; const bf16x8_t ak = *(const LAS bf16x8_t*)(buf + 32768 + row * 128 + ((cp ^ (row & 7)) << 4));
                        S[db] = __builtin_amdgcn_mfma_f32_32x32x16_bf16(ak, vb[jt][s], S[db], 0, 0, 0); }
                asm volatile("" ::: "memory");
            }
        }
        asm volatile("s_waitcnt lgkmcnt(0)" ::: "memory");
        __builtin_amdgcn_s_barrier();
        asm volatile("" ::: "memory");
    }
    asm volatile("s_waitcnt vmcnt(0)" ::: "memory");
    __builtin_amdgcn_s_barrier();
}

__device__ __forceinline__ void ph_gatednorm(const Ctx& c, const Args& a) {
    const bf16* O = WSP(bf16, O_O); const bf16* proj = WSP(bf16, O_PROJ); bf16* og = WSP(bf16, O_OG);
    const float* gn = a.in[5];
    for (int row = c.bid * 8 + c.wave; row < NT; row += c.G * 8) {
#pragma unroll
        for (int j = 0; j < 4; ++j) {
            const int col = 4 * c.lane + 256 * j;
            const f32x4 o = ld_bf16x4(O + (size_t)row * D + col), z = ld_bf16x4(proj + (size_t)row * 4096 + 3072 + col);
            float s = o.x * o.x + o.y * o.y + o.z * o.z + o.w * o.w;
#pragma unroll
            for (int m = 1; m < 32; m <<= 1) s += __shfl_xor(s, m);
            const float rs = rsqrtf(s * (1.f / 128.f) + NORM_EPS);
            const f32x4 g = *(const f32x4*)(gn + (col & 127));
            u32x2 w; w.x = pk2(o.x * rs * g.x * siluf_(z.x), o.y * rs * g.y * siluf_(z.y)); w.y = pk2(o.z * rs * g.z * siluf_(z.z), o.w * rs * g.w * siluf_(z.w));
            *(u32x2*)(og + (size_t)row * D + col) = w;
        }
    }
}

__device__ __forceinline__ void ph_proj1024(const Ctx& c, const bf16* A, const float* W, int ldw, bf16* C, float scale) {
    for (int u = c.bid; u < (NT / 128) * 8; u += c.G) {
        const int mb = u >> 3, nb = u & 7;
        gg_tile(c, D, ALin{A + (size_t)mb * 128 * D, D}, BPlain{W + nb * 128, ldw}, EBf16{C + (size_t)mb * 128 * D + nb * 128, D, scale});
    }
}

__device__ __forceinline__ void ln_finish(const Ctx& c, f32x4 (&v)[4], const float* g, const float* b, float* outf, bf16* outb, size_t row) {
    float s = 0.f;
#pragma unroll
    for (int j = 0; j < 4; ++j) s += (v[j].x + v[j].y) + (v[j].z + v[j].w);
    const float mean = wave_sum(s) * (1.f / D); float s2 = 0.f;
#pragma unroll
    for (int j = 0; j < 4; ++j) { v[j] = v[j] - mean; s2 += (v[j].x * v[j].x + v[j].y * v[j].y) + (v[j].z * v[j].z + v[j].w * v[j].w); }
    const float rstd = rsqrtf(wave_sum(s2) * (1.f / D) + LN_EPS);
#pragma unroll
    for (int j = 0; j < 4; ++j) {
        const int col = 4 * c.lane + 256 * j;
        const f32x4 gg = *(const f32x4*)(g + col), bb = *(const f32x4*)(b + col);
        const f32x4 o = v[j] * rstd * gg + bb;
        *(f32x4*)(outf + row * D + col) = o;
        if (outb) { u32x2 w; w.x = pk2(o.x, o.y); w.y = pk2(o.z, o.w); *(u32x2*)(outb + row * D + col) = w; }
    }
}
__device__ __forceinline__ void ph_ln_mix(const Ctx& c, const float* xin, const bf16* mix, const float* g, const float* b, float* outf, bf16* outb) {
    for (int row = c.bid * 8 + c.wave; row < NT; row += c.G * 8) {
        f32x4 v[4];
#pragma unroll
        for (int j = 0; j < 4; ++j) { const int col = 4 * c.lane + 256 * j; v[j] = *(const f32x4*)(xin + (size_t)row * D + col) * ALPHA + ld_bf16x4(mix + (size_t)row * D + col); }
        ln_finish(c, v, g, b, outf, outb, (size_t)row);
    }
}

__device__ __forceinline__ void ph_router_shared(const Ctx& c, const Args& a, int layer) {
    const bf16* xb = WSP(bf16, O_XB); float* logits = WSP(float, O_LOG); bf16* H = WSP(bf16, O_H);
    const float* wr = a.in[11] + (size_t)layer * D * NE; const float* wsg = a.in[15] + (size_t)layer * D * 512;
    for (int u = c.bid; u < (NT / 128) * 2; u += c.G) {
        const int mb = u >> 1, nb = u & 1;
        gg_tile(c, D, ALin{xb + (size_t)mb * 128 * D, D}, BPlain{wr + nb * 128, NE}, EF32{logits + (size_t)mb * 128 * NE + nb * 128, NE});
    }
    for (int u = c.bid; u < (NT / 128) * 4; u += c.G) {
        const int mb = u >> 2, nb = u & 3;
        gg_tile(c, D, ALin{xb + (size_t)mb * 128 * D, D}, BGateUp{wsg + nb * 64, 512, 256}, ESwiglu{H + (size_t)(SH0 + mb * 128) * DE + nb * 64, DE});
    }
}

__device__ __forceinline__ void ph_route(const Ctx& c, const Args& a, int layer) {
    LAS int* hist = (LAS int*)c.lds;
    LAS int* base = hist + 256;
    LAS int* rec_e = base + 256;
    LAS int* rec_r = rec_e + 1024;
    const float* logits = WSP(float, O_LOG); const float* rbias = a.in[12] + layer * NE;
    int* eidx = WSP(int, O_EIDX); int* slot = WSP(int, O_SLOT); float* gate = WSP(float, O_GATE); int* list = WSP(int, O_LIST);
    unsigned* counts = WSP(unsigned, O_CTL) + CW_CNT + 256 * layer;
    const float NINF = -__builtin_inff();
    for (int blk = c.bid; blk < NT / 128; blk += c.G) {
        if (c.tid < 256) hist[c.tid] = 0;
        __syncthreads();
        for (int i = 0; i < 16; ++i) {
            const int tl = c.wave * 16 + i, tok = blk * 128 + tl;
            const f32x4 lg = *(const f32x4*)(logits + (size_t)tok * NE + 4 * c.lane);
            const f32x4 bs = *(const f32x4*)(rbias + 4 * c.lane);
            float sc[4], sel[4];
#pragma unroll
            for (int j = 0; j < 4; ++j) { sc[j] = sigmoidf_(lg[j]); sel[j] = sc[j] + bs[j]; }
            float m1 = fmaxf(sel[0], sel[1]), m2 = fminf(sel[0], sel[1]);
#pragma unroll
            for (int j = 2; j < 4; ++j) { const float v = sel[j]; m2 = fmaxf(m2, fminf(m1, v)); m1 = fmaxf(m1, v); }
#pragma unroll
            for (int o = 1; o < 8; o <<= 1) { const float o1 = __shfl_xor(m1, o), o2 = __shfl_xor(m2, o); m2 = fmaxf(fminf(m1, o1), fmaxf(m2, o2)); m1 = fmaxf(m1, o1); }
            const float gs = m1 + m2; const int myg = c.lane >> 3; int rank = 0;
#pragma unroll
            for (int j = 0; j < 8; ++j) { const float s = __shfl(gs, 8 * j); rank += (s > gs || (s == gs && j < myg)) ? 1 : 0; }
            if (rank >= 4) { sel[0] = NINF; sel[1] = NINF; sel[2] = NINF; sel[3] = NINF; }
            float wsum = 0.f, myw = 0.f; int mye = 0;
#pragma unroll
            for (int r = 0; r < 8; ++r) {
                float bv = sel[0]; int bi = 4 * c.lane;
#pragma unroll
                for (int j = 1; j < 4; ++j) if (sel[j] > bv) { bv = sel[j]; bi = 4 * c.lane + j; }
#pragma unroll
                for (int o = 32; o >= 1; o >>= 1) { const float ov = __shfl_xor(bv, o); const int oi = __shfl_xor(bi, o); if (ov > bv || (ov == bv && oi < bi)) { bv = ov; bi = oi; } }
                const int own = bi >> 2, jj = bi & 3;
                float mine = sc[0]; mine = (jj == 1) ? sc[1] : mine; mine = (jj == 2) ? sc[2] : mine; mine = (jj == 3) ? sc[3] : mine;
                const float w = __shfl(mine, own);
                if (c.lane == own) { sel[0] = (jj == 0) ? NINF : sel[0]; sel[1] = (jj == 1) ? NINF : sel[1]; sel[2] = (jj == 2) ? NINF : sel[2]; sel[3] = (jj == 3) ? NINF : sel[3]; }
                wsum += w; if (c.lane == r) { myw = w; mye = bi; }
            }
            if (c.lane < 8) {
                const float gt = myw / wsum * ROUTED_SCALE;
                eidx[(size_t)tok * 8 + c.lane] = mye; gate[(size_t)tok * 8 + c.lane] = gt;
                rec_e[tl * 8 + c.lane] = mye; rec_r[tl * 8 + c.lane] = __hip_atomic_fetch_add(&hist[mye], 1, __ATOMIC_RELAXED, __HIP_MEMORY_SCOPE_WORKGROUP);
            }
        }
        __syncthreads();
        if (c.tid < 256) { const int n = hist[c.tid]; base[c.tid] = n ? (int)atomicAdd(&counts[c.tid], (unsigned)n) : 0; }
        __syncthreads();
        for (int i = c.tid; i < 1024; i += 512) {
            const int e = rec_e[i], s = base[e] + rec_r[i], tok = blk * 128 + (i >> 3);
            slot[(size_t)tok * 8 + (i & 7)] = s; list[(size_t)e * NT + s] = tok;
        }
        __syncthreads();
    }
}

__device__ __forceinline__ void moe_tables(const Ctx& c, int layer, LAS int* ts, LAS int* cnt) {
    const unsigned* counts = WSP(unsigned, O_CTL) + CW_CNT + 256 * layer;
    if (c.tid < 256) cnt[c.tid] = (int)__hip_atomic_load(counts + c.tid, __ATOMIC_RELAXED, __HIP_MEMORY_SCOPE_AGENT);
    __syncthreads();
    if (c.tid == 0) { int s = 0; for (int e = 0; e < 256; ++e) { ts[e] = s; s += (cnt[e] + 255) >> 8; } ts[256] = s; }
    __syncthreads();
}
__device__ __forceinline__ int find_expert(const LAS int* ts, int mt) { int lo = 0, hi = 255; while (lo < hi) { const int mid = (lo + hi + 1) >> 1; if (ts[mid] <= mt) lo = mid; else hi = mid - 1; } return lo; }

__device__ __forceinline__ void ph_moe_gu(const Ctx& c, const Args& a, int layer) {
    LAS int* ts = (LAS int*)(c.lds + 20480); LAS int* cnt = ts + 260; LAS int* rows = cnt + 256;
    moe_tables(c, layer, ts, cnt);
    const bf16* xb = WSP(bf16, O_XB); bf16* H = WSP(bf16, O_H); const int* list = WSP(int, O_LIST);
    const int ntile = ts[256];
    for (int u = c.bid; u < ntile * 8; u += c.G) {
        const int mt = u >> 3, sub = u & 7, rh = sub >> 2, cb = sub & 3;
        int e = find_expert(ts, mt);
        while (ts[e + 1] <= mt) ++e;
        __syncthreads();
        if (c.tid < 128) { const int s = (mt - ts[e]) * 256 + rh * 128 + c.tid; rows[c.tid] = s < cnt[e] ? list[(size_t)e * NT + s] : 0; }
        __syncthreads();
        const float* W = a.in[13] + ((size_t)layer * NE + e) * D * 512;
        gg_tile(c, D, AGather{xb, D, rows}, BGateUp{W + cb * 64, 512, 256}, ESwiglu{H + (size_t)(mt * 256 + rh * 128) * DE + cb * 64, DE});
    }
}
__device__ __forceinline__ void ph_moe_down(const Ctx& c, const Args& a, int layer) {
    LAS int* ts = (LAS int*)(c.lds + 20480); LAS int* cnt = ts + 260;
    moe_tables(c, layer, ts, cnt);
    const bf16* H = WSP(bf16, O_H); bf16* Y = WSP(bf16, O_Y);
    const int ntile = ts[256];
    for (int u = c.bid; u < (ntile + NT / 256) * 16; u += c.G) {
        const int mt = u >> 4, sub = u & 15, rh = sub >> 3, nb = sub & 7;
        const float* W; size_t row0;
        if (mt < ntile) { int e = find_expert(ts, mt); while (ts[e + 1] <= mt) ++e; W = a.in[14] + ((size_t)layer * NE + e) * DE * D; row0 = (size_t)mt * 256 + rh * 128; }
        else { W = a.in[16] + (size_t)layer * DE * D; row0 = (size_t)SH0 + (size_t)(mt - ntile) * 256 + rh * 128; }
        gg_tile(c, DE, ALin{H + row0 * DE, DE}, BPlain{W + nb * 128, D}, EBf16{Y + row0 * D + nb * 128, D, 1.f});
    }
}
__device__ __forceinline__ void ph_combine_ln(const Ctx& c, const Args& a, int layer, const float* xin, float* outf, bf16* outb) {
    LAS int* ts = (LAS int*)(c.lds + 20480); LAS int* cnt = ts + 260;
    moe_tables(c, layer, ts, cnt);
    const bf16* Y = WSP(bf16, O_Y); const int* eidx = WSP(int, O_EIDX); const int* slot = WSP(int, O_SLOT); const float* gate = WSP(float, O_GATE);
    const float* g = a.in[19] + layer * D; const float* b = a.in[20] + layer * D;
    for (int row = c.bid * 8 + c.wave; row < NT; row += c.G * 8) {
        int me = 0, ms = 0; float mg = 0.f;
        if (c.lane < 8) { me = eidx[(size_t)row * 8 + c.lane]; ms = slot[(size_t)row * 8 + c.lane]; mg = gate[(size_t)row * 8 + c.lane]; }
        const int myrow = (c.lane < 8) ? ts[me] * 256 + ms : 0;
        f32x4 v[4];
#pragma unroll
        for (int j = 0; j < 4; ++j) { const int col = 4 * c.lane + 256 * j; v[j] = *(const f32x4*)(xin + (size_t)row * D + col) * ALPHA + ld_bf16x4(Y + ((size_t)SH0 + row) * D + col); }
#pragma unroll
        for (int k = 0; k < 8; ++k) {
            const int yr = __shfl(myrow, k); const float gk = __shfl(mg, k);
#pragma unroll
            for (int j = 0; j < 4; ++j) { const int col = 4 * c.lane + 256 * j; v[j] += ld_bf16x4(Y + (size_t)yr * D + col) * gk; }
        }
        ln_finish(c, v, g, b, outf, outb, (size_t)row);
    }
}

__device__ __forceinline__ void ph_qkv(const Ctx& c, const Args& a) {
    const bf16* xb = WSP(bf16, O_XB); bf16* Q = WSP(bf16, O_Q); bf16* Kb = WSP(bf16, O_K); bf16* VT = WSP(bf16, O_VT);
    for (int u = c.bid; u < (NT / 128) * 24; u += c.G) {
        const int mb = u / 24, nb = u % 24;
        if (nb < 8) gg_tile(c, D, ALin{xb + (size_t)mb * 128 * D, D}, BPlain{a.in[8] + nb * 128, D}, EBf16{Q + (size_t)mb * 128 * D + nb * 128, D, 0.125f});
        else if (nb < 16) gg_tile(c, D, ALin{xb + (size_t)mb * 128 * D, D}, BPlain{a.in[7] + (nb - 8) * 128, 2048}, EBf16{Kb + (size_t)mb * 128 * D + (nb - 8) * 128, D, 1.f});
        else gg_tile(c, D, ALin{xb + (size_t)mb * 128 * D, D}, BPlain{a.in[7] + 1024 + (nb - 16) * 128, 2048}, EBf16T{VT + (size_t)(nb - 16) * 128 * NT + (size_t)mb * 128, NT});
    }
}
__device__ __forceinline__ void ph_attn_golden(const Ctx& c, const Args& a) {
    const bf16* Q = WSP(bf16, O_Q); const bf16* Kb = WSP(bf16, O_K); const bf16* VT = WSP(bf16, O_VT); bf16* AO = WSP(bf16, O_OG);
    const float* relb = a.in[9];
    for (int u = c.bid * 8 + c.wave; u < NB * NCH * AH; u += c.G * 8) {
        const int h = u % AH, bc = u / AH, ch = bc % NCH, b = bc / NCH;
        const size_t tok = (size_t)b * SEQ + ch * 64 + c.lane;
        float q[64], o[64];
#pragma unroll
        for (int d = 0; d < 64; d += 4) { const f32x4 t = ld_bf16x4(Q + tok * D + h * 64 + d); q[d] = t.x; q[d + 1] = t.y; q[d + 2] = t.z; q[d + 3] = t.w; }
#pragma unroll
        for (int d = 0; d < 64; ++d) o[d] = 0.f;
        float m = -1e30f, l = 0.f;
        const int j0 = (ch < LEFT) ? (LEFT - ch) * 64 : 0;
        for (int j = j0; j < BAND; ++j) {
            const int kpos = ch * 64 - LEFT * 64 + j;
            const bf16* kr = Kb + ((size_t)b * SEQ + kpos) * D + h * 64;
            float s = 0.f;
#pragma unroll
            for (int d = 0; d < 64; d += 4) { const f32x4 t = ld_bf16x4(kr + d); s += q[d] * t.x + q[d + 1] * t.y + q[d + 2] * t.z + q[d + 3] * t.w; }
            int rel = c.lane + LEFT * 64 - j; rel = rel < -63 ? -63 : (rel > 256 ? 256 : rel);
            s += relb[h * RELN + rel + 63];
            const float mn = fmaxf(m, s), corr = __expf(m - mn), p = __expf(s - mn);
            l = l * corr + p; m = mn;
            const bf16* vc = VT + (size_t)(h * 64) * NT + (size_t)b * SEQ + kpos;
#pragma unroll
            for (int d = 0; d < 64; ++d) o[d] = o[d] * corr + p * bf2f(vc[(size_t)d * NT]);
        }
        const float il = 1.f / l;
#pragma unroll
        for (int d = 0; d < 64; d += 4) { u32x2 w; w.x = pk2(o[d] * il, o[d + 1] * il); w.y = pk2(o[d + 2] * il, o[d + 3] * il); *(u32x2*)(AO + tok * D + h * 64 + d) = w; }
    }
}

__device__ __forceinline__ void ph_attn(const Ctx& c, const Args& a) {
    LAS float* rb = (LAS float*)c.lds;
    for (int i = c.tid; i < AH * RELN; i += 512) rb[i] = a.in[9][i];
    __syncthreads();
    const bf16* Q = WSP(bf16, O_Q); const bf16* Kb = WSP(bf16, O_K); const bf16* VT = WSP(bf16, O_VT); bf16* AO = WSP(bf16, O_OG);
    const int r = c.lane & 31, hh = c.lane >> 5;
    for (int wu = c.bid * 8 + c.wave; wu < NB * NCH * AH * 2; wu += c.G * 8) {
        const int qh = wu & 1, h = (wu >> 1) & 15, bc = wu >> 5, ch = bc % NCH, b = bc / NCH;
        const size_t tokq = (size_t)b * SEQ + ch * 64 + qh * 32 + r;
        bf16x8_t qf[4];
#pragma unroll
        for (int s = 0; s < 4; ++s) qf[s] = *(const bf16x8_t*)(Q + tokq * D + h * 64 + 16 * s + 8 * hh);
        f32x16 oacc[2];
#pragma unroll
        for (int j = 0; j < 16; ++j) { oacc[0][j] = 0.f; oacc[1][j] = 0.f; }
        float m = -1e30f, l = 0.f;
        const LAS float* rbh = rb + h * RELN;
        const float bmax = rbh[RELN - 1];
        const int kt0 = (ch < LEFT) ? 2 * (LEFT - ch) : 0;
        for (int kt = kt0; kt < 18; ++kt) {
            const int kpos0 = ch * 64 - LEFT * 64 + 32 * kt;
            const bf16* kr = Kb + ((size_t)b * SEQ + kpos0 + r) * D + h * 64 + 8 * hh;
            f32x16 sa;
#pragma unroll
            for (int j = 0; j < 16; ++j) sa[j] = 0.f;
#pragma unroll
            for (int s = 0; s < 4; ++s) { const bf16x8_t kf = *(const bf16x8_t*)(kr + 16 * s); sa = __builtin_amdgcn_mfma_f32_32x32x16_bf16(kf, qf[s], sa, 0, 0, 0); }
            if (32 * kt <= 225 + 32 * qh) {
#pragma unroll
                for (int j = 0; j < 16; ++j) sa[j] += bmax;
            } else {
                const int rel0 = 32 * qh + r + LEFT * 64 - 32 * kt - 4 * hh + 63;
#pragma unroll
                for (int j = 0; j < 16; ++j) { int idx = rel0 - ((j & 3) + 8 * (j >> 2)); idx = idx > 319 ? 319 : idx; sa[j] += rbh[idx]; }
            }
            float mx = sa[0];
#pragma unroll
            for (int j = 1; j < 16; ++j) mx = fmaxf(mx, sa[j]);
            mx = fmaxf(mx, __shfl_xor(mx, 32));
            const float mn = fmaxf(m, mx), corr = __expf(m - mn);
            float ps = 0.f;
#pragma unroll
            for (int j = 0; j < 16; ++j) { sa[j] = __expf(sa[j] - mn); ps += sa[j]; }
            ps += __shfl_xor(ps, 32);
            l = l * corr + ps; m = mn;
#pragma unroll
            for (int j = 0; j < 16; ++j) { oacc[0][j] *= corr; oacc[1][j] *= corr; }
            bf16x8_t pb[2]; pb[0] = pack8(sa, 0); pb[1] = pack8(sa, 1);
            const bf16* vr = VT + (size_t)(h * 64 + r) * NT + (size_t)b * SEQ + kpos0 + 4 * hh;
#pragma unroll
            for (int dt = 0; dt < 2; ++dt)
#pragma unroll
                for (int s = 0; s < 2; ++s) { const u32x2 v0 = *(const u32x2*)(vr + (size_t)dt * 32 * NT + 16 * s), v1 = *(const u32x2*)(vr + (size_t)dt * 32 * NT + 16 * s + 8);
                    u32x4 vv; vv.x = v0.x; vv.y = v0.y; vv.z = v1.x; vv.w = v1.y;
                    oacc[dt] = __builtin_amdgcn_mfma_f32_32x32x16_bf16(__builtin_bit_cast(bf16x8_t, vv), pb[s], oacc[dt], 0, 0, 0); }
        }
        const float inv = 1.f / l;
#pragma unroll
        for (int dt = 0; dt < 2; ++dt)
#pragma unroll
            for (int qd = 0; qd < 4; ++qd) { u32x2 w; w.x = pg8::cvt_pk_bf16(oacc[dt][4 * qd] * inv, oacc[dt][4 * qd + 1] * inv); w.y = pg8::cvt_pk_bf16(oacc[dt][4 * qd + 2] * inv, oacc[dt][4 * qd + 3] * inv);
                *(u32x2*)(AO + tokq * D + h * 64 + 32 * dt + 8 * qd + 4 * hh) = w; }
    }
}

constexpr int LDS_TAB = pg8::STAGE_BYTES;
__device__ __forceinline__ int vcu_of(const Ctx& c) { return (c.G % 8 == 0) ? (c.bid & 7) * (c.G >> 3) + (c.bid >> 3) : c.bid; }
__device__ __forceinline__ void ph_dense1024(const Ctx& c, const bf16* A, const bf16* Bt, bf16* O) {
    pg8::DenseSched S; S.T.init(NT / 256, 4, c.G, c.bid); S.A = A; S.Bt = Bt; S.K = D; S.O = O; S.ldc = D; S.scale = 1.f;
    pg8::gemm_run(c.tid, c.lds, (const LAS int*)(c.lds + LDS_TAB), D, S, pg8::EpiBf16{});
}
__device__ __forceinline__ void ph_qkv_fast(const Ctx& c) {
    pg8::QkvSched S; S.T1.init(NT / 256, 8, c.G, c.bid); S.T2.init(4, NT / 256, c.G, c.bid); S.G = c.G; S.c = c.bid;
    S.XB = WSP(bf16, O_XB); S.WQK = WSP(bf16, O_WQK); S.WV = WSP(bf16, O_WV); S.Q = WSP(bf16, O_Q); S.Kb = WSP(bf16, O_K); S.VT = WSP(bf16, O_VT);
    pg8::gemm_run(c.tid, c.lds, (const LAS int*)(c.lds + LDS_TAB), D, S, pg8::EpiBf16{});
}
__device__ __forceinline__ void ph_router_shared_fast(const Ctx& c, int layer) {
    pg8::RouterSharedSched S; S.G = c.G; S.c = c.bid; S.XB = WSP(bf16, O_XB); S.WRS = WSP(bf16, O_WRS) + (size_t)layer * 768 * D; S.logits = WSP(float, O_LOG); S.H = WSP(bf16, O_H);
    pg8::gemm_run(c.tid, c.lds, (const LAS int*)(c.lds + LDS_TAB), D, S, pg8::EpiMoe{});
}
__device__ __forceinline__ void ph_moe_gu_fast(const Ctx& c, int layer) {
    LAS int* ts = (LAS int*)(c.lds + LDS_TAB); LAS int* cnt = ts + 260; LAS int* rows = cnt + 256;
    moe_tables(c, layer, ts, cnt);
    const int ntile = ts[256], vc = vcu_of(c); const int* list = WSP(int, O_LIST);
    for (int i = 0; i < 12; ++i) {
        const int L = i * c.G + vc; if (L >= 2 * ntile) break;
        const int mt = L >> 1; const int e = find_expert(ts, mt);
        if (c.tid < 256) { const int sl = (mt - ts[e]) * 256 + c.tid; rows[i * 256 + c.tid] = sl < cnt[e] ? list[(size_t)e * NT + sl] : 0; }
    }
    __syncthreads();
    pg8::MoeGuSched S; S.G = c.G; S.vc = vc; S.ntile = ntile; S.ts = ts; S.XB = WSP(bf16, O_XB); S.WGU = WSP(bf16, O_WGU) + (size_t)layer * NE * 512 * D; S.H = WSP(bf16, O_H);
    pg8::gemm_run(c.tid, c.lds, rows, D, S, pg8::EpiMoe{});
}
__device__ __forceinline__ void ph_moe_down_fast(const Ctx& c, int layer) {
    LAS int* ts = (LAS int*)(c.lds + LDS_TAB); LAS int* cnt = ts + 260;
    moe_tables(c, layer, ts, cnt);
    pg8::MoeDownSched S; S.G = c.G; S.vc = vcu_of(c); S.ntile = ts[256]; S.ts = ts; S.H = WSP(bf16, O_H); S.WD = WSP(bf16, O_WD) + (size_t)layer * NE * D * DE; S.WSD = WSP(bf16, O_WSD) + (size_t)layer * D * DE; S.Y = WSP(bf16, O_Y);
    int Kd = DE; asm volatile("" : "+s"(Kd));
    pg8::gemm_run(c.tid, c.lds, (const LAS int*)(c.lds + LDS_TAB), Kd, S, pg8::EpiBf16{});
}

__device__ __forceinline__ bool fresh(Ctx& c) { int t = threadIdx.x; asm volatile("" : "+v"(t)); c.tid = t; c.lane = t & 63; c.wave = __builtin_amdgcn_readfirstlane(t >> 6); return true; }
__global__ void __launch_bounds__(512, 2) fwd(Args args) {
    extern __shared__ __attribute__((aligned(16))) unsigned char lds_raw[];
    Ctx c; c.lds = (LAS unsigned char*)lds_raw; c.ws = args.ws;
    c.tid = threadIdx.x; c.lane = c.tid & 63; c.wave = __builtin_amdgcn_readfirstlane(c.tid >> 6); c.bid = blockIdx.x; c.G = gridDim.x;
    volatile LAS unsigned* xbw = (volatile LAS unsigned*)(c.lds + LDS_BYTES - 16);
    if (c.tid == 0) { xbw[0] = 0u; xbw[1] = 0u; }
    __syncthreads();
    XcdBarrier bar; bar.bar = (unsigned*)(args.ws + O_CTL) + CW_BAR; bar.x = 0; bar.st = xbw;
#if !MK_SPLIT
    bar = xcd_barrier_post((unsigned*)(args.ws + O_CTL) + CW_BAR, xbw);
#endif
    const int lo = args.ph_lo, hi = args.ph_hi;
#ifndef PH_MASK
#define PH_MASK 0x1FFFFFu
#endif
#define IN(k) (((PH_MASK >> (k)) & 1u) && lo <= (k) && (k) < hi && fresh(c))
#if MK_SPLIT
#define SEAM(k) do { } while (0)
#else
#define SEAM(k) do { if (lo <= (k) && (k) + 1 < hi) xcd_barrier(bar); } while (0)
#endif
    float* XFA = (float*)(args.ws + O_XFA); float* XFB = (float*)(args.ws + O_XFB); bf16* XBp = (bf16*)(args.ws + O_XB);
    bf16* OG = (bf16*)(args.ws + O_OG); bf16* MIX = (bf16*)(args.ws + O_MIX);
    if (IN(0)) { ph_prologue(c, args); __syncthreads(); const int gw = c.bid * 8 + c.wave, NGW = c.G * 8;
        cvt_small_weights(c, args, gw, NGW); cvt_expert_weights(c, args, gw, NGW, 0); cvt_expert_weights(c, args, gw, NGW, 1); }
    SEAM(0);
    if (IN(1)) ph_inproj(c, args);
    SEAM(1);
#if DELTA_GOLDEN
    if (IN(2)) ph_delta_golden(c, args);
    SEAM(2);
    SEAM(3);
#else
    if (IN(2)) ph_delta_d1(c, args);
    SEAM(2);
    if (IN(3)) ph_delta_d2(c);
    SEAM(3);
#endif
    if (IN(4)) ph_gatednorm(c, args);
    SEAM(4);
    if (IN(5)) ph_dense1024(c, OG, (const bf16*)(args.ws + O_WOA), MIX);
    SEAM(5);
    if (IN(6)) ph_ln_mix(c, args.in[0], MIX, args.in[17], args.in[18], XFA, XBp);
    SEAM(6);
    if (IN(7)) ph_router_shared_fast(c, 0);
    SEAM(7);
    if (IN(8)) ph_route(c, args, 0);
    SEAM(8);
    if (IN(9)) ph_moe_gu_fast(c, 0);
    SEAM(9);
    if (IN(10)) ph_moe_down_fast(c, 0);
    SEAM(10);
    if (IN(11)) ph_combine_ln(c, args, 0, XFA, XFB, XBp);
    SEAM(11);
    if (IN(12)) ph_qkv_fast(c);
    SEAM(12);
    if (IN(13)) ph_attn(c, args);
    SEAM(13);
    if (IN(14)) ph_dense1024(c, OG, (const bf16*)(args.ws + O_WOB), MIX);
    SEAM(14);
    if (IN(15)) ph_ln_mix(c, XFB, MIX, args.in[17] + D, args.in[18] + D, XFA, XBp);
    SEAM(15);
    if (IN(16)) ph_router_shared_fast(c, 1);
    SEAM(16);
    if (IN(17)) ph_route(c, args, 1);
    SEAM(17);
    if (IN(18)) ph_moe_gu_fast(c, 1);
    SEAM(18);
    if (IN(19)) ph_moe_down_fast(c, 1);
    SEAM(19);
    if (IN(20)) ph_combine_ln(c, args, 1, XFA, args.out, nullptr);
#undef IN
#undef SEAM
}

extern "C" void kernel_launch(void* const* d_in, const int* in_sizes, int n_in, void* d_out, int out_size, void* d_ws, size_t ws_size, hipStream_t stream) {
    static int grid = 0;
    if (grid == 0) {
        if (n_in != 21 || out_size != NT * D || ws_size < O_END) { fprintf(stderr, "kernel_launch: unexpected problem: n_in %d out %d ws %zu (need %zu)\n", n_in, out_size, ws_size, (size_t)O_END); grid = -1; return; }
        int dev = 0, cus = 0, per_cu = 0;
        if (hipGetDevice(&dev) != hipSuccess || hipDeviceGetAttribute(&cus, hipDeviceAttributeMultiprocessorCount, dev) != hipSuccess) { grid = -1; return; }
        if (hipFuncSetAttribute((const void*)fwd, hipFuncAttributeMaxDynamicSharedMemorySize, LDS_BYTES) != hipSuccess) { fprintf(stderr, "kernel_launch: hipFuncSetAttribute failed\n"); grid = -1; return; }
        if (hipOccupancyMaxActiveBlocksPerMultiprocessor(&per_cu, (const void*)fwd, 512, LDS_BYTES) != hipSuccess || per_cu < 1) fprintf(stderr, "kernel_launch: occupancy query says %d\n", per_cu);
        (void)hipGetLastError();
        grid = cus;
    }
    if (grid < 0) return;
    (void)hipMemsetAsync((char*)d_ws + O_CTL, 0, CTL_BYTES, stream);
    Args a{};
    for (int i = 0; i < 21; ++i) a.in[i] = (const float*)d_in[i];
    a.out = (float*)d_out; a.ws = (unsigned char*)d_ws;
#if MK_SPLIT
    for (int p = 0; p < NPHASE; ++p) { a.ph_lo = p; a.ph_hi = p + 1; hipLaunchKernelGGL(fwd, dim3(grid), dim3(512), LDS_BYTES, stream, a); }
#else
    a.ph_lo = 0; a.ph_hi = NPHASE; hipLaunchKernelGGL(fwd, dim3(grid), dim3(512), LDS_BYTES, stream, a);
#endif
}
```

```cpp
#include <hip/hip_runtime.h>
#include <cstdio>
#include <cstdint>

#ifndef DUP_MASK
#define DUP_MASK 0u
#endif
#ifndef DELTA_GOLDEN
#define DELTA_GOLDEN 0
#endif
#ifndef MK_SPLIT
#define MK_SPLIT 0
#endif

#define GAS __attribute__((address_space(1)))
#define LAS __attribute__((address_space(3)))
typedef unsigned short bf16;
typedef float f32x4 __attribute__((ext_vector_type(4)));
typedef float f32x2 __attribute__((ext_vector_type(2)));
typedef unsigned u32x2 __attribute__((ext_vector_type(2)));
typedef unsigned u32x4 __attribute__((ext_vector_type(4)));

constexpr int NB = 4, SEQ = 8192, NT = NB * SEQ, D = 1024;
constexpr int DNH = 8, DK = 128, DV = 128, INW = 4112, QKVW = 3072;
constexpr int AH = 16, DH = 64, CHUNK = 64, NCH = SEQ / CHUNK, LEFT = 8, BAND = (LEFT + 1) * CHUNK, RELN = 320;
constexpr int NE = 256, TOPK = 8, DE = 256;
constexpr float ALPHA = 1.41421356237f, LN_EPS = 1e-5f, NORM_EPS = 1e-6f, ROUTED_SCALE = 2.5f;
constexpr int SH0 = 327680;
constexpr int HROWS = SH0 + NT;
constexpr int NPHASE = 21;

constexpr size_t MiB = 1u << 20;
constexpr size_t O_CTL = 0, CTL_BYTES = 1 * MiB;
constexpr size_t O_XB = O_CTL + CTL_BYTES;
constexpr size_t O_XFA = O_XB + (size_t)NT * D * 2;
constexpr size_t O_XFB = O_XFA + (size_t)NT * D * 4;
constexpr size_t O_AB = O_XFB + (size_t)NT * D * 4;
constexpr size_t O_PROJ = O_AB + (size_t)NT * 16 * 4;
constexpr size_t O_O = O_PROJ + (size_t)NT * 4096 * 2;
constexpr size_t O_OG = O_O + (size_t)NT * D * 2;
constexpr size_t O_MIX = O_OG + (size_t)NT * D * 2;
constexpr size_t O_LOG = O_MIX + (size_t)NT * D * 2;
constexpr size_t O_EIDX = O_LOG + (size_t)NT * NE * 4;
constexpr size_t O_SLOT = O_EIDX + (size_t)NT * 8 * 4;
constexpr size_t O_GATE = O_SLOT + (size_t)NT * 8 * 4;
constexpr size_t O_LIST = O_GATE + (size_t)NT * 8 * 4;
constexpr size_t O_H = O_LIST + (size_t)NE * NT * 4;
constexpr size_t O_Y = O_H + (size_t)HROWS * DE * 2;
constexpr size_t O_Q = O_Y + (size_t)HROWS * D * 2;
constexpr size_t O_K = O_Q + (size_t)NT * D * 2;
constexpr size_t O_VT = O_K + (size_t)NT * D * 2;
constexpr size_t O_WIN = O_VT + (size_t)NT * D * 2;
constexpr size_t O_WOA = O_WIN + (size_t)4096 * D * 2;
constexpr size_t O_WQK = O_WOA + (size_t)D * D * 2;
constexpr size_t O_WV = O_WQK + (size_t)2048 * D * 2;
constexpr size_t O_WOB = O_WV + (size_t)D * D * 2;
constexpr size_t O_WRS = O_WOB + (size_t)D * D * 2;
constexpr size_t O_WSD = O_WRS + (size_t)2 * 768 * D * 2;
constexpr size_t O_WGU = O_WSD + (size_t)2 * D * DE * 2;
constexpr size_t O_WD = O_WGU + (size_t)2 * NE * 512 * D * 2;
constexpr size_t O_DU = O_WD + (size_t)2 * NE * D * DE * 2;
constexpr size_t DU_NW = 0, DU_QG = 16384, DU_KDT = 32768, DU_P = 49152, DU_U = 57344, DU_BYTES = 73728;
constexpr int NUNIT = NB * DNH * NCH;
constexpr size_t O_EGL = O_DU + (size_t)NUNIT * DU_BYTES;
constexpr size_t O_END = O_EGL + (size_t)NUNIT * 4;
constexpr int CW_BAR = 4096;
constexpr int CW_CNT = 16384;

constexpr int LDS_BYTES = 160 * 1024;

struct Args { const float* in[21]; float* out; unsigned char* ws; int ph_lo, ph_hi; };

__device__ __forceinline__ unsigned f2bf(float f) { unsigned u = __builtin_bit_cast(unsigned, f); return (u + 0x7fffu + ((u >> 16) & 1u)) >> 16; }
__device__ __forceinline__ float bf2f(unsigned b) { return __builtin_bit_cast(float, b << 16); }
typedef __bf16 bf16x2_t __attribute__((ext_vector_type(2)));
__device__ __forceinline__ unsigned pk2(float lo, float hi) { const f32x2 v = {lo, hi}; return __builtin_bit_cast(unsigned, __builtin_convertvector(v, bf16x2_t)); }
__device__ __forceinline__ float wave_sum(float v) {
#pragma unroll
    for (int o = 1; o < 64; o <<= 1) v += __shfl_xor(v, o);
    return v;
}
__device__ __forceinline__ float sigmoidf_(float x) { return 1.0f / (1.0f + __expf(-x)); }
__device__ __forceinline__ float siluf_(float x) { return x / (1.0f + __expf(-x)); }

#define XB_TMO      128
#define XB_XCNT(j)  (256  + 64 * (j))
#define XB_XSUB(j)  (1280 + 64 * (j))
#define XB_XGEN(j)  (2304 + 64 * (j))
#define XB_TOP      3328
#define XB_TOPGEN   3392
#define XCD_BAR_WORDS 3456
#define XB_SPIN_CAP (1u << 18)
__device__ __forceinline__ unsigned xb_ld(unsigned* p)              { return __hip_atomic_load(p, __ATOMIC_RELAXED, __HIP_MEMORY_SCOPE_AGENT); }
__device__ __forceinline__ unsigned xb_add(unsigned* p, unsigned v) { return __hip_atomic_fetch_add(p, v, __ATOMIC_RELAXED, __HIP_MEMORY_SCOPE_AGENT); }
__device__ __forceinline__ unsigned xb_xcc_id() { return (unsigned)__builtin_amdgcn_s_getreg((3 << 11) | 20) & 0xFu; }
#define XB_SPIN(cond, bar) do { unsigned _sp = 0; while (cond) { __builtin_amdgcn_s_sleep(1); \
    if ((++_sp & 255u) == 0u) { if (xb_ld(&(bar)[XB_TMO])) break; if (_sp > XB_SPIN_CAP) { atomicAdd(&(bar)[XB_TMO], 1u); break; } } } } while (0)
struct XcdBarrier { unsigned* bar; unsigned x; volatile LAS unsigned* st; };
__device__ __forceinline__ XcdBarrier xcd_barrier_post(unsigned* bar, volatile LAS unsigned* st) {
    XcdBarrier b; b.bar = bar; b.x = xb_xcc_id(); b.st = st;
    if (threadIdx.x == 0) (void)xb_add(&bar[XB_XCNT(b.x)], 1u);
    return b;
}
__device__ __forceinline__ void xcd_barrier_complete(unsigned* bar, unsigned x, unsigned& nloc, unsigned& nx) {
    const unsigned G = gridDim.x * gridDim.y * gridDim.z;
    unsigned sum, cnt, mine, sp = 0u;
    for (;;) {
        sum = 0u; cnt = 0u; mine = 0u;
#pragma unroll
        for (unsigned j = 0; j < 16; ++j) { const unsigned c = xb_ld(&bar[XB_XCNT(j)]); sum += c; cnt += (c > 0u) ? 1u : 0u; mine = (j == x) ? c : mine; }
        if (sum == G) break;
        __builtin_amdgcn_s_sleep(1);
        if ((++sp & 255u) == 0u) { if (xb_ld(&bar[XB_TMO])) break; if (sp > XB_SPIN_CAP) { atomicAdd(&bar[XB_TMO], 1u); break; } }
    }
    nloc = mine > 0u ? mine : 1u; nx = cnt > 0u ? cnt : 1u;
}
__device__ __forceinline__ void xcd_barrier(const XcdBarrier& b) {
    asm volatile("s_waitcnt vmcnt(0)" ::: "memory");
    __syncthreads();
    if (threadIdx.x == 0) {
        unsigned* bar = b.bar;
        __builtin_amdgcn_s_waitcnt(0);
        unsigned nloc = b.st[0], nx = b.st[1];
        if (nloc == 0u) { xcd_barrier_complete(bar, b.x, nloc, nx); b.st[0] = nloc; b.st[1] = nx; }
        const unsigned old = xb_add(&bar[XB_XSUB(b.x)], 1u);
        const unsigned gen = old / nloc;
        if (old + 1u == (gen + 1u) * nloc) {
            __builtin_amdgcn_fence(__ATOMIC_RELEASE, "agent");
            asm volatile("s_waitcnt vmcnt(0)" ::: "memory");
            const unsigned og = xb_add(&bar[XB_TOP], 1u);
            const unsigned tg = og / nx;
            if (og + 1u == (tg + 1u) * nx) xb_add(&bar[XB_TOPGEN], 1u);
            else XB_SPIN(xb_ld(&bar[XB_TOPGEN]) == tg, bar);
            __builtin_amdgcn_fence(__ATOMIC_ACQUIRE, "agent");
            xb_add(&bar[XB_XGEN(b.x)], 1u);
            asm volatile("s_waitcnt vmcnt(0)" ::: "memory");
        } else {
            XB_SPIN(xb_ld(&bar[XB_XGEN(b.x)]) == gen, bar);
            __builtin_amdgcn_fence(__ATOMIC_ACQUIRE, "agent");
            asm volatile("s_waitcnt vmcnt(0)" ::: "memory");
        }
    }
    __syncthreads();
}

struct Ctx {
    LAS unsigned char* lds; unsigned char* ws;
    int tid, lane, wave, bid, G;
};
#define WSP(T, off) ((T*)(c.ws + (off)))

__device__ __forceinline__ void ph_prologue(const Ctx& c, const Args& a) {
    LAS float* W = (LAS float*)c.lds;
    const float* win = a.in[1];
    for (int i = c.tid; i < 1024 * 16; i += 512) { const int k = i >> 4, j = i & 15; W[k * 20 + j] = win[(size_t)k * INW + 4096 + j]; }
    __syncthreads();
    const float* x = a.in[0]; bf16* xb = WSP(bf16, O_XB); float* ab = WSP(float, O_AB);
    for (int row = c.bid * 8 + c.wave; row < NT; row += c.G * 8) {
        float acc[16];
#pragma unroll
        for (int n = 0; n < 16; ++n) acc[n] = 0.f;
#pragma unroll 1
        for (int j = 0; j < 4; ++j) {
            const f32x4 v = ((const f32x4*)(x + (size_t)row * D))[c.lane + 64 * j];
            u32x2 w2; w2.x = pk2(v.x, v.y); w2.y = pk2(v.z, v.w); ((u32x2*)(xb + (size_t)row * D))[c.lane + 64 * j] = w2;
#pragma unroll
            for (int i = 0; i < 4; ++i) {
                const int k = 4 * c.lane + 256 * j + i; const float xv = v[i];
#pragma unroll
                for (int q = 0; q < 4; ++q) { const f32x4 w = *(const LAS f32x4*)(W + k * 20 + 4 * q);
                    acc[4 * q + 0] += xv * w.x; acc[4 * q + 1] += xv * w.y; acc[4 * q + 2] += xv * w.z; acc[4 * q + 3] += xv * w.w; }
            }
        }
        float r = 0.f;
#pragma unroll
        for (int n = 0; n < 16; ++n) { const float s = wave_sum(acc[n]); r = (c.lane == n) ? s : r; }
        if (c.lane < 16) ab[(size_t)row * 16 + c.lane] = r;
    }
}

template <class AF, class BF, class EF>
__device__ __forceinline__ void gg_tile(const Ctx& c, int K, const AF& afn, const BF& bfn, const EF& efn) {
    LAS float* As = (LAS float*)c.lds;
    LAS float* Bs = As + 16 * 132;
    const int ty = c.tid >> 4, tx = c.tid & 15;
    const int ar = c.tid >> 2, ak = (c.tid & 3) * 4, bk = c.tid >> 5, bq = c.tid & 31;
    float acc[4][8];
#pragma unroll
    for (int i = 0; i < 4; ++i)
#pragma unroll
        for (int j = 0; j < 8; ++j) acc[i][j] = 0.f;
    for (int k0 = 0; k0 < K; k0 += 16) {
        const f32x4 av = afn(ar, k0 + ak);
        const f32x4 bv = bfn(k0 + bk, bq);
        __syncthreads();
        As[(ak + 0) * 132 + ar] = av.x; As[(ak + 1) * 132 + ar] = av.y; As[(ak + 2) * 132 + ar] = av.z; As[(ak + 3) * 132 + ar] = av.w;
        *(LAS f32x4*)(Bs + bk * 128 + bq * 4) = bv;
        __syncthreads();
#pragma unroll 4
        for (int kk = 0; kk < 16; ++kk) {
            const f32x4 a4 = *(const LAS f32x4*)(As + kk * 132 + ty * 4);
            const f32x4 b0 = *(const LAS f32x4*)(Bs + kk * 128 + tx * 8), b1 = *(const LAS f32x4*)(Bs + kk * 128 + tx * 8 + 4);
#pragma unroll
            for (int i = 0; i < 4; ++i) {
                acc[i][0] += a4[i] * b0.x; acc[i][1] += a4[i] * b0.y; acc[i][2] += a4[i] * b0.z; acc[i][3] += a4[i] * b0.w;
                acc[i][4] += a4[i] * b1.x; acc[i][5] += a4[i] * b1.y; acc[i][6] += a4[i] * b1.z; acc[i][7] += a4[i] * b1.w;
            }
        }
    }
#pragma unroll
    for (int i = 0; i < 4; ++i) efn(ty * 4 + i, tx * 8, acc[i]);
}
__device__ __forceinline__ f32x4 ld_bf16x4(const bf16* p) { const u32x2 w = *(const u32x2*)p; return (f32x4){bf2f(w.x & 0xffffu), bf2f(w.x >> 16), bf2f(w.y & 0xffffu), bf2f(w.y >> 16)}; }
struct ALin { const bf16* base; int lda; __device__ __forceinline__ f32x4 operator()(int r, int k) const { return ld_bf16x4(base + (size_t)r * lda + k); } };
struct AGather { const bf16* base; int lda; const LAS int* rows; __device__ __forceinline__ f32x4 operator()(int r, int k) const { return ld_bf16x4(base + (size_t)rows[r] * lda + k); } };
struct BPlain { const float* B; int ldb; __device__ __forceinline__ f32x4 operator()(int k, int q) const { return *(const f32x4*)(B + (size_t)k * ldb + 4 * q); } };
struct BGateUp { const float* B; int ldb; int up_off; __device__ __forceinline__ f32x4 operator()(int k, int q) const {
    const f32x2 g = *(const f32x2*)(B + (size_t)k * ldb + 2 * q), u = *(const f32x2*)(B + (size_t)k * ldb + up_off + 2 * q); return (f32x4){g.x, u.x, g.y, u.y}; } };
struct EBf16 { bf16* C; int ldc; float scale; __device__ __forceinline__ void operator()(int r, int cb, const float (&v)[8]) const {
    u32x4 w; w.x = pk2(v[0] * scale, v[1] * scale); w.y = pk2(v[2] * scale, v[3] * scale); w.z = pk2(v[4] * scale, v[5] * scale); w.w = pk2(v[6] * scale, v[7] * scale);
    *(u32x4*)(C + (size_t)r * ldc + cb) = w; } };
struct EBf16T { bf16* C; int ldc; __device__ __forceinline__ void operator()(int r, int cb, const float (&v)[8]) const {
#pragma unroll
    for (int j = 0; j < 8; ++j) C[(size_t)(cb + j) * ldc + r] = (bf16)f2bf(v[j]); } };
struct EF32 { float* C; int ldc; __device__ __forceinline__ void operator()(int r, int cb, const float (&v)[8]) const {
    *(f32x4*)(C + (size_t)r * ldc + cb) = (f32x4){v[0], v[1], v[2], v[3]}; *(f32x4*)(C + (size_t)r * ldc + cb + 4) = (f32x4){v[4], v[5], v[6], v[7]}; } };
struct ESwiglu { bf16* H; int ldh; __device__ __forceinline__ void operator()(int r, int cb, const float (&v)[8]) const {
    u32x2 w; w.x = pk2(siluf_(v[0]) * v[1], siluf_(v[2]) * v[3]); w.y = pk2(siluf_(v[4]) * v[5], siluf_(v[6]) * v[7]);
    *(u32x2*)(H + (size_t)r * ldh + (cb >> 1)) = w; } };

__device__ __forceinline__ void cvt_item(const float* W, int ldw, int K, int N, bf16* WT, LAS float* scr, int item, int lane) {
    const int nblk = N >> 5, kb = item / nblk, nb = item - kb * nblk, k0 = 64 * kb, n0 = 32 * nb;
#pragma unroll 8
    for (int i = 0; i < 32; ++i) { const int kk = 2 * i + (lane >> 5); scr[kk * 33 + (lane & 31)] = W[(size_t)(k0 + kk) * ldw + n0 + (lane & 31)]; }
    asm volatile("s_waitcnt lgkmcnt(0)" ::: "memory");
    const int cc = lane & 7;
#pragma unroll
    for (int j = 0; j < 4; ++j) { const int n = (lane >> 3) + 8 * j; const LAS float* sp = scr + (8 * cc) * 33 + n;
        u32x4 o; o.x = pk2(sp[0 * 33], sp[1 * 33]); o.y = pk2(sp[2 * 33], sp[3 * 33]); o.z = pk2(sp[4 * 33], sp[5 * 33]); o.w = pk2(sp[6 * 33], sp[7 * 33]);
        *(u32x4*)(WT + (size_t)(n0 + n) * K + k0 + 8 * cc) = o; }
    asm volatile("s_waitcnt lgkmcnt(0)" ::: "memory");
}
__device__ __forceinline__ void cvt_range(const Ctx& c, int gw, int NGW, const float* W, int ldw, int K, int N, int nmat, size_t sstride, bf16* WT, size_t dstride) {
    LAS float* scr = (LAS float*)(c.lds + c.wave * 8704);
    const int per = (K >> 6) * (N >> 5), total = per * nmat;
    for (int it = gw; it < total; it += NGW) { const int mi = it / per, r = it - mi * per; cvt_item(W + (size_t)mi * sstride, ldw, K, N, WT + (size_t)mi * dstride, scr, r, c.lane); }
}
__device__ __forceinline__ void cvt_small_weights(const Ctx& c, const Args& a, int gw, int NGW) {
    cvt_range(c, gw, NGW, a.in[1], INW, D, 4096, 1, 0, WSP(bf16, O_WIN), 0);
    cvt_range(c, gw, NGW, a.in[6], D, D, D, 1, 0, WSP(bf16, O_WOA), 0);
    cvt_range(c, gw, NGW, a.in[8], D, D, D, 1, 0, WSP(bf16, O_WQK), 0);
    cvt_range(c, gw, NGW, a.in[7], 2048, D, D, 1, 0, WSP(bf16, O_WQK) + (size_t)D * D, 0);
    cvt_range(c, gw, NGW, a.in[7] + 1024, 2048, D, D, 1, 0, WSP(bf16, O_WV), 0);
    cvt_range(c, gw, NGW, a.in[10], D, D, D, 1, 0, WSP(bf16, O_WOB), 0);
    cvt_range(c, gw, NGW, a.in[11], NE, D, NE, 2, (size_t)D * NE, WSP(bf16, O_WRS), (size_t)768 * D);
    cvt_range(c, gw, NGW, a.in[15], 512, D, 512, 2, (size_t)D * 512, WSP(bf16, O_WRS) + (size_t)256 * D, (size_t)768 * D);
    cvt_range(c, gw, NGW, a.in[16], D, DE, D, 2, (size_t)DE * D, WSP(bf16, O_WSD), (size_t)D * DE);
}
__device__ __forceinline__ void cvt_expert_weights(const Ctx& c, const Args& a, int gw, int NGW, int layer) {
    cvt_range(c, gw, NGW, a.in[13] + (size_t)layer * NE * D * 512, 512, D, 512, NE, (size_t)D * 512, WSP(bf16, O_WGU) + (size_t)layer * NE * 512 * D, (size_t)512 * D);
    cvt_range(c, gw, NGW, a.in[14] + (size_t)layer * NE * DE * D, D, DE, D, NE, (size_t)DE * D, WSP(bf16, O_WD) + (size_t)layer * NE * D * DE, (size_t)D * DE);
}

namespace pg8 {
typedef short bf16x8 __attribute__((ext_vector_type(8)));
constexpr int BM = 256, BK = 64, HALF = 128, HTB = HALF * BK * 2, STAGE_BYTES = 8 * HTB, NXCD = 8, WGM = 8;
__device__ __forceinline__ int lds_byte(int r, int c) { const int st = (r >> 4) * 2 + (c >> 5), rr = r & 15, cc = c & 31, ob = rr * 64 + cc * 2; return st * 1024 + (ob ^ (((ob >> 9) & 1) << 5)); }
__device__ __forceinline__ void stage_rc(int b, int& R, int& C) { const int st = b / 1024, sb = b % 1024, swz = sb ^ (((sb >> 9) & 1) << 5); R = (st >> 1) * 16 + swz / 64; C = (st & 1) * 32 + (swz % 64) / 2; }
__device__ __forceinline__ int perm32(int rho) { const int n = rho >> 4, i = rho & 15; return 8 * (i >> 2) + 4 * n + (i & 3); }
__device__ __forceinline__ unsigned cvt_pk_bf16(float lo, float hi) { return pk2(lo, hi); }

struct GUnit {
    const char* A;
    const char* B;
    unsigned bh;
    int arow;
    int rl;
    char* optr; int ldc; int aux; float scale;
};
struct TileOrder {
    int nM, nN, nwg, G, c;
    __device__ __forceinline__ void init(int nM_, int nN_, int G_, int c_) { nM = nM_; nN = nN_; nwg = nM * nN; G = G_; c = c_; }
    __device__ __forceinline__ bool tile(int i, int& pm, int& pn) const { const long L = (long)i * G + c; if (L >= nwg) return false; at((int)L, pm, pn); return true; }
    __device__ __forceinline__ void at(int L, int& pm, int& pn) const {
        int wgid = L; { const int q = nwg / NXCD, r = nwg % NXCD, xcd = wgid % NXCD, off = wgid / NXCD; wgid = (xcd < r ? xcd * (q + 1) : r * (q + 1) + (xcd - r) * q) + off; }
        const int nig = WGM * nN, gid = wgid / nig, fm = gid * WGM, gsz = (nM - fm) < WGM ? (nM - fm) : WGM;
        pm = fm + ((wgid % nig) % gsz); pn = (wgid % nig) / gsz;
    }
};
template <class Epi, class Sched>
__device__ __forceinline__ void gemm_run(const int tid, LAS unsigned char* lds, const LAS int* rows, const int K, const Sched& S, const Epi& E) {
    const int wid = __builtin_amdgcn_readfirstlane(tid >> 6), lane = tid & 63, wr = wid >> 2, wc = wid & 3, fr = lane & 15, fq = lane >> 4;
    const int nt = K / BK;
    int R[2], C[2]; unsigned voffB[2];
#pragma unroll
    for (int i = 0; i < 2; ++i) { stage_rc(tid * 16 + i * 8192, R[i], C[i]); const int Rb = (R[i] & ~31) + perm32(R[i] & 31); voffB[i] = (unsigned)(Rb * K + C[i]) * 2u; }
    const size_t kstep = (size_t)(BK * 2);
    const unsigned ldsw = (unsigned)wid * 1024u;
    const int aoff = lds_byte(wr * 64 + fr, fq * 8), boff = lds_byte(wc * 32 + fr, fq * 8);
#define PG8_SA(b, h) (((b) * 2 + (h)) * HTB)
#define PG8_SB(b, h) ((4 + (b) * 2 + (h)) * HTB)
#define PG8_STAGE(bufoff, gbase, voff) do { _Pragma("unroll") for (int _i = 0; _i < 2; ++_i) \
        __builtin_amdgcn_global_load_lds((const unsigned*)((const char*)(gbase) + (voff)[_i]), (LAS unsigned*)(lds + (bufoff) + ldsw + _i * 8192), 16, 0, 0); } while (0)
#define PG8_LDA(dst, b, h) do { _Pragma("unroll") for (int m = 0; m < 4; ++m) _Pragma("unroll") for (int k = 0; k < 2; ++k) dst[m][k] = *(const LAS bf16x8*)(lds + PG8_SA(b, h) + aoff + m * 2048 + k * 1024); } while (0)
#define PG8_LDB(dst, b, h) do { _Pragma("unroll") for (int n = 0; n < 2; ++n) _Pragma("unroll") for (int k = 0; k < 2; ++k) dst[n][k] = *(const LAS bf16x8*)(lds + PG8_SB(b, h) + boff + n * 2048 + k * 1024); } while (0)
#define PG8_MMA(ai, bj, At, Bt) do { __builtin_amdgcn_s_setprio(1); _Pragma("unroll") for (int m = 0; m < 4; ++m) _Pragma("unroll") for (int n = 0; n < 2; ++n) _Pragma("unroll") for (int k = 0; k < 2; ++k) \
        acc[ai][bj][m][n] = __builtin_amdgcn_mfma_f32_16x16x32_bf16(Bt[n][k], At[m][k], acc[ai][bj][m][n], 0, 0, 0); __builtin_amdgcn_s_setprio(0); } while (0)
#define PG8_WAIT_V(n) asm volatile("s_waitcnt vmcnt(" #n ")" ::: "memory")
#define PG8_WAIT_L(n) asm volatile("s_waitcnt lgkmcnt(" #n ")" ::: "memory")
#define PG8_BAR __builtin_amdgcn_s_barrier()
#define PG8_SCHED __builtin_amdgcn_sched_barrier(0)
#define PG8_AOFF(u, dst) do { _Pragma("unroll") for (int _h = 0; _h < 2; ++_h) _Pragma("unroll") for (int _i = 0; _i < 2; ++_i) { const int _r = _h * HALF + R[_i]; \
        const int _row = (u).arow >= 0 ? (u).arow + _r : rows[(u).rl + _r]; dst[_h][_i] = (unsigned)(_row * K + C[_i]) * 2u; } } while (0)
    GUnit cur, nxt; int ui = 0;
    if (!S.next(0, cur)) return;
    f32x4 acc[2][2][4][2];
#pragma unroll
    for (int a = 0; a < 2; ++a)
#pragma unroll
        for (int b = 0; b < 2; ++b)
#pragma unroll
            for (int m = 0; m < 4; ++m)
#pragma unroll
                for (int n = 0; n < 2; ++n) acc[a][b][m][n] = (f32x4){0.f, 0.f, 0.f, 0.f};
    bf16x8 At[4][2], B0[2][2], B1[2][2];
    unsigned cO[2][2], nO[2][2];
    PG8_AOFF(cur, cO);
    const char* cA = cur.A; const char* cB = cur.B; unsigned cbh = cur.bh;
    PG8_STAGE(PG8_SB(0, 0), cB, voffB); PG8_STAGE(PG8_SB(0, 1), cB + cbh, voffB); PG8_STAGE(PG8_SA(0, 0), cA, cO[0]); PG8_STAGE(PG8_SA(0, 1), cA, cO[1]);
    if (wr == 1) PG8_BAR;
    PG8_WAIT_V(2); PG8_BAR;
    PG8_STAGE(PG8_SB(1, 0), cB + kstep, voffB); PG8_STAGE(PG8_SA(1, 0), cA + kstep, cO[0]); PG8_STAGE(PG8_SB(1, 1), cB + cbh + kstep, voffB);
    PG8_WAIT_V(6); PG8_BAR;
    for (;;) {
        const bool has_next = S.next(ui + 1, nxt);
        const char* nA = cA; const char* nB = cB; unsigned nbh = cbh;
#pragma unroll
        for (int h = 0; h < 2; ++h)
#pragma unroll
            for (int i = 0; i < 2; ++i) nO[h][i] = cO[h][i];
        if (has_next) { nA = nxt.A; nB = nxt.B; nbh = nxt.bh; PG8_AOFF(nxt, nO); }
        for (int t = 0; t < nt; t += 2) {
            const bool last = (t == nt - 2);
            const char* a1 = cA + (size_t)(t + 1) * kstep;
            const char* a2 = last ? nA : cA + (size_t)(t + 2) * kstep; const char* b2 = last ? nB : cB + (size_t)(t + 2) * kstep;
            const unsigned bh2 = last ? nbh : cbh;
            unsigned o2[2][2];
#pragma unroll
            for (int h = 0; h < 2; ++h)
#pragma unroll
                for (int i = 0; i < 2; ++i) o2[h][i] = last ? nO[h][i] : cO[h][i];
            const char* a3 = a2 + kstep; const char* b3 = b2 + kstep;
            PG8_LDB(B0, 0, 0); PG8_LDB(B1, 0, 1); PG8_SCHED; PG8_LDA(At, 0, 0); PG8_STAGE(PG8_SA(1, 1), a1, cO[1]);
            PG8_WAIT_V(8); PG8_WAIT_L(0); PG8_BAR; PG8_MMA(0, 0, At, B0); PG8_MMA(0, 1, At, B1); PG8_BAR; PG8_SCHED;
            PG8_LDA(At, 0, 1); PG8_STAGE(PG8_SB(0, 0), b2, voffB); PG8_STAGE(PG8_SB(0, 1), b2 + bh2, voffB); PG8_STAGE(PG8_SA(0, 0), a2, o2[0]);
            PG8_WAIT_V(8); PG8_WAIT_L(0); PG8_BAR; PG8_MMA(1, 0, At, B0); PG8_MMA(1, 1, At, B1); PG8_BAR; PG8_SCHED;
            PG8_LDB(B0, 1, 0); PG8_LDB(B1, 1, 1); PG8_SCHED; PG8_LDA(At, 1, 0); PG8_STAGE(PG8_SA(0, 1), a2, o2[1]);
            PG8_WAIT_V(8); PG8_WAIT_L(0); PG8_BAR; PG8_MMA(0, 0, At, B0); PG8_MMA(0, 1, At, B1); PG8_BAR; PG8_SCHED;
            PG8_LDA(At, 1, 1); PG8_STAGE(PG8_SB(1, 0), b3, voffB); PG8_STAGE(PG8_SB(1, 1), b3 + bh2, voffB); PG8_STAGE(PG8_SA(1, 0), a3, o2[0]);
            PG8_WAIT_V(8); PG8_WAIT_L(0); PG8_BAR; PG8_MMA(1, 0, At, B0); PG8_MMA(1, 1, At, B1); PG8_BAR; PG8_SCHED;
        }
        if (wr == 0) PG8_BAR;
        E(acc, cur, wr, wc, fr, fq);
        if (!has_next) break;
#pragma unroll
        for (int a = 0; a < 2; ++a)
#pragma unroll
            for (int b = 0; b < 2; ++b)
#pragma unroll
                for (int m = 0; m < 4; ++m)
#pragma unroll
                    for (int n = 0; n < 2; ++n) acc[a][b][m][n] = (f32x4){0.f, 0.f, 0.f, 0.f};
        cur = nxt; cA = nA; cB = nB; cbh = nbh; ++ui;
#pragma unroll
        for (int h = 0; h < 2; ++h)
#pragma unroll
            for (int i = 0; i < 2; ++i) cO[h][i] = nO[h][i];
        if (wr == 1) PG8_BAR;
    }
    PG8_WAIT_V(0);
    PG8_BAR;
#undef PG8_SA
#undef PG8_SB
#undef PG8_STAGE
#undef PG8_LDA
#undef PG8_LDB
#undef PG8_MMA
#undef PG8_WAIT_V
#undef PG8_WAIT_L
#undef PG8_BAR
#undef PG8_SCHED
#undef PG8_AOFF
}
struct EpiBf16 {
    __device__ __forceinline__ void operator()(const f32x4 (&acc)[2][2][4][2], const GUnit& u, int wr, int wc, int fr, int fq) const {
        bf16* base = (bf16*)u.optr + (size_t)(wr * 64 + fr) * u.ldc + wc * 32 + 8 * fq; const float sc = u.scale;
#pragma unroll
        for (int ai = 0; ai < 2; ++ai)
#pragma unroll
            for (int m = 0; m < 4; ++m) { bf16* rowp = base + (size_t)(ai * HALF + m * 16) * u.ldc;
#pragma unroll
                for (int bj = 0; bj < 2; ++bj) { const f32x4 v0 = acc[ai][bj][m][0] * sc, v1 = acc[ai][bj][m][1] * sc;
                    u32x4 w; w.x = cvt_pk_bf16(v0[0], v0[1]); w.y = cvt_pk_bf16(v0[2], v0[3]); w.z = cvt_pk_bf16(v1[0], v1[1]); w.w = cvt_pk_bf16(v1[2], v1[3]);
                    *(u32x4*)(rowp + bj * HALF) = w; } }
    }
};
struct DenseSched {
    TileOrder T; const bf16* A; const bf16* Bt; int K; bf16* O; int ldc; float scale;
    __device__ __forceinline__ bool next(int i, GUnit& u) const {
        int pm, pn; if (!T.tile(i, pm, pn)) return false;
        u.A = (const char*)A; u.B = (const char*)(Bt + (size_t)pn * BM * K); u.bh = (unsigned)(HALF * K * 2); u.arow = pm * BM; u.rl = 0;
        u.optr = (char*)(O + (size_t)pm * BM * ldc + pn * BM); u.ldc = ldc; u.aux = 0; u.scale = scale; return true;
    }
};
struct QkvSched {
    TileOrder T1, T2; int G, c; const bf16 *XB, *WQK, *WV; bf16 *Q, *Kb, *VT;
    __device__ __forceinline__ bool next(int i, GUnit& u) const {
        const int L = i * G + c; if (L >= 1536) return false;
        int pm, pn; u.bh = (unsigned)(HALF * D * 2); u.rl = 0; u.aux = 0;
        if (L < 1024) { T1.at(L, pm, pn); u.A = (const char*)XB; u.B = (const char*)(WQK + (size_t)pn * BM * D); u.arow = pm * BM; u.ldc = D;
            if (pn < 4) { u.optr = (char*)(Q + (size_t)pm * BM * D + pn * BM); u.scale = 0.125f; } else { u.optr = (char*)(Kb + (size_t)pm * BM * D + (pn - 4) * BM); u.scale = 1.f; } }
        else { T2.at(L - 1024, pm, pn); u.A = (const char*)WV; u.B = (const char*)(XB + (size_t)pn * BM * D); u.arow = pm * BM; u.ldc = NT; u.optr = (char*)(VT + (size_t)pm * BM * NT + (size_t)pn * BM); u.scale = 1.f; }
        return true;
    }
};
struct EpiMoe {
    __device__ __forceinline__ void operator()(const f32x4 (&acc)[2][2][4][2], const GUnit& u, int wr, int wc, int fr, int fq) const {
        if (u.aux == 0) {
            bf16* base = (bf16*)u.optr + (size_t)(wr * 64 + fr) * u.ldc + wc * 32 + 8 * fq;
#pragma unroll
            for (int ai = 0; ai < 2; ++ai)
#pragma unroll
                for (int m = 0; m < 4; ++m) { float hv[8];
#pragma unroll
                    for (int n = 0; n < 2; ++n)
#pragma unroll
                        for (int j = 0; j < 4; ++j) { const float g = acc[ai][0][m][n][j], up = acc[ai][1][m][n][j]; hv[4 * n + j] = g * __builtin_amdgcn_rcpf(1.0f + __expf(-g)) * up; }
                    u32x4 w; w.x = cvt_pk_bf16(hv[0], hv[1]); w.y = cvt_pk_bf16(hv[2], hv[3]); w.z = cvt_pk_bf16(hv[4], hv[5]); w.w = cvt_pk_bf16(hv[6], hv[7]);
                    *(u32x4*)(base + (size_t)(ai * HALF + m * 16) * u.ldc) = w; }
        } else {
            float* base = (float*)u.optr + (size_t)(wr * 64 + fr) * u.ldc + wc * 32 + 8 * fq;
#pragma unroll
            for (int ai = 0; ai < 2; ++ai)
#pragma unroll
                for (int m = 0; m < 4; ++m) { float* rowp = base + (size_t)(ai * HALF + m * 16) * u.ldc;
#pragma unroll
                    for (int bj = 0; bj < 2; ++bj) { *(f32x4*)(rowp + bj * HALF) = acc[ai][bj][m][0]; *(f32x4*)(rowp + bj * HALF + 4) = acc[ai][bj][m][1]; } }
        }
    }
};
struct RouterSharedSched {
    int G, c; const bf16 *XB, *WRS; float* logits; bf16* H;
    __device__ __forceinline__ bool next(int i, GUnit& u) const {
        const int L = i * G + c; if (L >= 384) return false;
        u.A = (const char*)XB; u.rl = 0; u.scale = 1.f;
        if (L < 256) { const int pm = L >> 1, nh = L & 1; u.arow = pm * BM; u.B = (const char*)(WRS + (size_t)(256 + nh * HALF) * D); u.bh = (unsigned)(256 * D * 2);
            u.optr = (char*)(H + (size_t)(SH0 + pm * BM) * DE + nh * HALF); u.ldc = DE; u.aux = 0; }
        else { const int pm = L - 256; u.arow = pm * BM; u.B = (const char*)WRS; u.bh = (unsigned)(HALF * D * 2); u.optr = (char*)(logits + (size_t)pm * BM * NE); u.ldc = NE; u.aux = 1; }
        return true;
    }
};
struct MoeGuSched {
    int G, vc, ntile; const LAS int* ts; const bf16 *XB, *WGU; bf16* H;
    __device__ __forceinline__ bool next(int i, GUnit& u) const {
        const int L = i * G + vc; if (L >= 2 * ntile) return false;
        const int mt = L >> 1, nh = L & 1; int lo = 0, hi = 255; while (lo < hi) { const int mid = (lo + hi + 1) >> 1; if (ts[mid] <= mt) lo = mid; else hi = mid - 1; }
        const int e = __builtin_amdgcn_readfirstlane(lo);
        u.A = (const char*)XB; u.arow = -1; u.rl = i * BM; u.B = (const char*)(WGU + ((size_t)e * 512 + nh * HALF) * D); u.bh = (unsigned)(256 * D * 2);
        u.optr = (char*)(H + (size_t)mt * BM * DE + nh * HALF); u.ldc = DE; u.aux = 0; u.scale = 1.f; return true;
    }
};
struct MoeDownSched {
    int G, vc, ntile; const LAS int* ts; const bf16 *H, *WD, *WSD; bf16* Y;
    __device__ __forceinline__ bool next(int i, GUnit& u) const {
        const int L = i * G + vc; if (L >= 4 * (ntile + NT / BM)) return false;
        const int mt = L >> 2, pn = L & 3; u.A = (const char*)H; u.rl = 0; u.bh = (unsigned)(HALF * DE * 2); u.ldc = D; u.aux = 0; u.scale = 1.f;
        if (mt < ntile) { int lo = 0, hi = 255; while (lo < hi) { const int mid = (lo + hi + 1) >> 1; if (ts[mid] <= mt) lo = mid; else hi = mid - 1; }
            const int e = __builtin_amdgcn_readfirstlane(lo);
            u.arow = mt * BM; u.B = (const char*)(WD + ((size_t)e * D + pn * BM) * DE); u.optr = (char*)(Y + (size_t)mt * BM * D + pn * BM); }
        else { const int row0 = SH0 + (mt - ntile) * BM; u.arow = row0; u.B = (const char*)(WSD + (size_t)pn * BM * DE); u.optr = (char*)(Y + (size_t)row0 * D + pn * BM); }
        return true;
    }
};
}

__device__ __forceinline__ void ph_inproj_golden(const Ctx& c, const Args& a) {
    const bf16* xb = WSP(bf16, O_XB); bf16* proj = WSP(bf16, O_PROJ);
    for (int u = c.bid; u < (NT / 128) * 32; u += c.G) {
        const int mb = u >> 5, nb = u & 31;
        gg_tile(c, D, ALin{xb + (size_t)mb * 128 * D, D}, BPlain{a.in[1] + nb * 128, INW}, EBf16{proj + (size_t)mb * 128 * 4096 + nb * 128, 4096, 1.f});
    }
}

__device__ __forceinline__ void ph_inproj(const Ctx& c, const Args& a) {
    pg8::DenseSched S; S.T.init(NT / 256, 4096 / 256, c.G, c.bid); S.A = WSP(bf16, O_XB); S.Bt = WSP(bf16, O_WIN); S.K = D; S.O = WSP(bf16, O_PROJ); S.ldc = 4096; S.scale = 1.f;
    pg8::gemm_run(c.tid, c.lds, (const LAS int*)(c.lds + pg8::STAGE_BYTES), D, S, pg8::EpiBf16{});
}
__device__ __forceinline__ void ph_delta_golden(const Ctx& c, const Args& a) {
    LAS float* raw = (LAS float*)c.lds;
    LAS float* red = raw + 384;
    LAS float* red2 = red + 512;
    LAS float* nrm = red2 + 512;
    const bf16* proj = WSP(bf16, O_PROJ); const float* ab = WSP(float, O_AB); bf16* O = WSP(bf16, O_O);
    const float* convw = a.in[2];
    for (int bh = c.bid; bh < NB * DNH; bh += c.G) {
        const int b = bh / DNH, h = bh % DNH;
        const int e = c.tid & 127, part = c.tid >> 7;
        float S[32];
#pragma unroll
        for (int i = 0; i < 32; ++i) S[i] = 0.f;
        const int ch = c.tid;
        const int col = (ch >> 7) * 1024 + h * 128 + (ch & 127);
        float w0 = 0, w1 = 0, w2 = 0, w3 = 0, x0 = 0, x1 = 0, x2 = 0;
        if (ch < 384) { w0 = convw[0 * QKVW + col]; w1 = convw[1 * QKVW + col]; w2 = convw[2 * QKVW + col]; w3 = convw[3 * QKVW + col]; }
        const float Ah = __expf(a.in[3][h]), dtb = a.in[4][h];
        for (int t = 0; t < SEQ; ++t) {
            const size_t tok = (size_t)b * SEQ + t;
            if (ch < 384) { const float x3 = bf2f(proj[tok * 4096 + col]); const float y = x0 * w0 + x1 * w1 + x2 * w2 + x3 * w3; raw[ch] = siluf_(y); x0 = x1; x1 = x2; x2 = x3; }
            __syncthreads();
            if (c.wave < 2) { const float v0 = raw[c.wave * 128 + c.lane], v1 = raw[c.wave * 128 + 64 + c.lane]; const float s = wave_sum(v0 * v0 + v1 * v1); if (c.lane == 0) nrm[c.wave] = s; }
            __syncthreads();
            const float rq = rsqrtf(nrm[0] + NORM_EPS) * 0.08838834764831845f, rk = rsqrtf(nrm[1] + NORM_EPS);
            const float av = ab[tok * 16 + h], bv = ab[tok * 16 + 8 + h];
            const float xx = av + dtb; const float sp = xx > 20.f ? xx : log1pf(__expf(xx));
            const float dec = __expf(-Ah * sp), beta = sigmoidf_(bv);
            float r = 0.f;
#pragma unroll
            for (int i = 0; i < 32; ++i) { S[i] *= dec; r += raw[128 + part * 32 + i] * rk * S[i]; }
            red[part * 128 + e] = r;
            __syncthreads();
            const float rr = red[e] + red[128 + e] + red[256 + e] + red[384 + e];
            const float vnew = beta * (raw[256 + e] - rr);
            float o = 0.f;
#pragma unroll
            for (int i = 0; i < 32; ++i) { S[i] += raw[128 + part * 32 + i] * rk * vnew; o += raw[part * 32 + i] * rq * S[i]; }
            red2[part * 128 + e] = o;
            __syncthreads();
            if (part == 0) { const float oo = red2[e] + red2[128 + e] + red2[256 + e] + red2[384 + e]; O[tok * D + h * 128 + e] = (bf16)f2bf(oo); }
        }
        __syncthreads();
    }
}

__device__ __forceinline__ int perm16(int x) { return (((x >> 2) & 1) << 3) + ((x >> 3) << 2) + (x & 3); }
__device__ __forceinline__ void ph_delta_d1(const Ctx& c, const Args& a, const int wm = 7) {
    constexpr int LD = 129;
    LAS float* qs = (LAS float*)c.lds;
    LAS float* ks = qs + 64 * LD;
    LAS float* vs = ks + 64 * LD;
    LAS float* At = vs + 64 * LD;
    LAS float* Tm = At + 64 * 65;
    LAS float* Xm = Tm + 64 * 65;
    LAS float* gcs = Xm + 32 * 33;
    LAS float* bts = gcs + 64;
    LAS float* rn = bts + 64;
    const bf16* proj = WSP(bf16, O_PROJ); const float* ab = WSP(float, O_AB); const float* convw = a.in[2];
    for (int uid = c.bid; uid < NUNIT; uid += c.G) {
        const int n = uid % NCH, bh = uid / NCH, h = bh % DNH, b = bh / DNH;
        const size_t tok0 = (size_t)b * SEQ + n * CHUNK;
        unsigned char* blk = c.ws + O_DU + (size_t)uid * DU_BYTES;
        __syncthreads();
        int tid = c.tid, lane = c.lane; asm volatile("" : "+v"(tid), "+v"(lane));
        if (tid < 384) {
            const int quad = tid % 96, tb = tid / 96, ch0 = quad * 4, mat = ch0 >> 7, cc = ch0 & 127;
            const int col = mat * 1024 + h * 128 + cc;
            f32x4 w[4];
#pragma unroll
            for (int j = 0; j < 4; ++j) w[j] = *(const f32x4*)(convw + j * QKVW + col);
            f32x4 hist[3];
#pragma unroll
            for (int j = 0; j < 3; ++j) { const int t = n * CHUNK + tb * 16 - 3 + j; hist[j] = t >= 0 ? ld_bf16x4(proj + ((size_t)b * SEQ + t) * 4096 + col) : (f32x4){0.f, 0.f, 0.f, 0.f}; }
            LAS float* dst = (mat == 0 ? qs : (mat == 1 ? ks : vs));
#pragma unroll 2
            for (int t = 0; t < 16; ++t) {
                const f32x4 x = ld_bf16x4(proj + (tok0 + tb * 16 + t) * 4096 + col);
                const f32x4 y = hist[0] * w[0] + hist[1] * w[1] + hist[2] * w[2] + x * w[3];
                hist[0] = hist[1]; hist[1] = hist[2]; hist[2] = x;
                LAS float* d = dst + (tb * 16 + t) * LD + cc;
                d[0] = siluf_(y.x); d[1] = siluf_(y.y); d[2] = siluf_(y.z); d[3] = siluf_(y.w);
            }
        }
        if (c.wave == 7) {
            const float av = ab[(tok0 + lane) * 16 + h], bv = ab[(tok0 + lane) * 16 + 8 + h];
            const float xx = av + a.in[4][h]; const float sp = xx > 20.f ? xx : log1pf(__expf(xx));
            float g = -__expf(a.in[3][h]) * sp;
#pragma unroll
            for (int o = 1; o < 64; o <<= 1) { const float t = __shfl_up(g, o); if (lane >= o) g += t; }
            gcs[lane] = g; bts[lane] = sigmoidf_(bv);
        }
        __syncthreads();
        if (tid < 128) { const int m = tid >> 6, t = tid & 63; const LAS float* r = (m ? ks : qs) + t * LD; float sm = 0.f; for (int d = 0; d < 128; ++d) sm += r[d] * r[d];
            rn[m * 64 + t] = rsqrtf(sm + NORM_EPS) * (m ? 1.f : 0.08838834764831845f); }
        __syncthreads();
        for (int i = tid; i < 64 * 128; i += 512) { const int t = i >> 7, d = i & 127; qs[t * LD + d] *= rn[t]; ks[t * LD + d] *= rn[64 + t]; }
        __syncthreads();
        const float gl = gcs[63];
        if (tid == 0) WSP(float, O_EGL)[uid] = __expf(gl);
        {
            const int i = tid >> 3, jg = tid & 7; float kk[8], qk[8];
#pragma unroll
            for (int j = 0; j < 8; ++j) { kk[j] = 0.f; qk[j] = 0.f; }
            if (jg * 8 <= i)
#pragma unroll 2
            for (int d = 0; d < 128; ++d) { const float ki = ks[i * LD + d], qi = qs[i * LD + d];
#pragma unroll
                for (int j = 0; j < 8; ++j) { const float kj = ks[(jg * 8 + j) * LD + d]; kk[j] += ki * kj; qk[j] += qi * kj; } }
            const float gci = gcs[i], bi = bts[i]; unsigned short pv[8];
#pragma unroll
            for (int j = 0; j < 8; ++j) { const int jj = jg * 8 + j; const float dec = (jj <= i) ? __expf(gci - gcs[jj]) : 0.f;
                At[jj * 65 + i] = (jj < i) ? bi * kk[j] * dec : 0.f; pv[j] = (unsigned short)f2bf(qk[j] * dec); }
            bf16* P = (bf16*)(blk + DU_P) + i * 64;
            if (wm & 1)
#pragma unroll
            for (int j = 0; j < 8; ++j) P[(jg * 8 & ~15) + perm16((jg * 8 + j) & 15)] = pv[j];
        }
        __syncthreads();
        if (c.wave == 0) {
            const int o0 = (lane >> 5) * 32, ii = lane & 31; LAS float* Tr = Tm + lane * 65 + o0;
            if (o0 == 0) for (int j = 0; j < 32; ++j) Tm[lane * 65 + 32 + j] = 0.f;
#pragma unroll 1
            for (int j = 31; j >= 0; --j) { float sacc = (ii == j) ? 1.f : 0.f; const LAS float* Ar = At + (o0 + j) * 65 + o0;
#pragma unroll 1
                for (int k = j + 1; k < 32; ++k) sacc -= Tr[k] * Ar[k];
                Tr[j] = sacc; }
        }
        __syncthreads();
        for (int i = tid; i < 1024; i += 512) { const int r = i >> 5, cc = i & 31; float sm = 0.f; for (int k = 0; k < 32; ++k) sm += At[k * 65 + 32 + r] * Tm[k * 65 + cc]; Xm[r * 33 + cc] = sm; }
        __syncthreads();
        for (int i = tid; i < 1024; i += 512) { const int r = i >> 5, cc = i & 31; float sm = 0.f; for (int k = 0; k < 32; ++k) sm += Tm[(32 + r) * 65 + 32 + k] * Xm[k * 33 + cc]; Tm[(32 + r) * 65 + cc] = -sm; }
        __syncthreads();
        {
            const int i = tid >> 3, cg = tid & 7; float uu[16], ww[16];
#pragma unroll
            for (int q = 0; q < 16; ++q) { uu[q] = 0.f; ww[q] = 0.f; }
#pragma unroll 1
            for (int j = 0; j <= i; ++j) { const float t = Tm[i * 65 + j] * bts[j], te = t * __expf(gcs[j]);
#pragma unroll
                for (int q = 0; q < 16; ++q) { uu[q] += t * vs[j * LD + cg * 16 + q]; ww[q] += te * ks[j * LD + cg * 16 + q]; } }
            bf16* U = (bf16*)(blk + DU_U); bf16* NW = (bf16*)(blk + DU_NW) + i * 128 + cg * 16;
            const int rt = i >> 5, ri = i & 31, hh = (ri >> 2) & 1, rg = 4 * (ri >> 3) + (ri & 3), hf = rg >> 3;
#pragma unroll
            for (int q = 0; q < 16; ++q) { const int e = cg * 16 + q, sl = e >> 5, ln = (e & 31) + 32 * hh;
                if (wm & 2) U[((((sl * 2 + rt) * 2 + hf) * 64 + ln) * 8) + (rg & 7)] = (bf16)f2bf(uu[q]); if (wm & 16) NW[perm16(q)] = (bf16)f2bf(-ww[q]); }
        }
        if (wm & 4) for (int i = tid; i < 64 * 128; i += 512) { const int t = i >> 7, d = i & 127; ((bf16*)(blk + DU_QG))[t * 128 + (d & ~15) + perm16(d & 15)] = (bf16)f2bf(qs[t * LD + d] * __expf(gcs[t])); }
        if (wm & 4) for (int i = tid; i < 64 * 128; i += 512) { const int d = i >> 6, t = i & 63; ((bf16*)(blk + DU_KDT))[d * 64 + (t & ~15) + perm16(t & 15)] = (bf16)f2bf(ks[t * LD + d] * __expf(gl - gcs[t])); }
    }
}
typedef short bf16x8_t __attribute__((ext_vector_type(8)));
typedef float f32x16 __attribute__((ext_vector_type(16)));
__device__ __forceinline__ bf16x8_t pack8(const f32x16& x, int s);
__device__ __forceinline__ void ph_delta_d1_fast(const Ctx& c, const Args& a) {
    constexpr int LQ = 136, LT = 72, LA = 68;
    LAS bf16* QH = (LAS bf16*)c.lds;
    LAS bf16* KH = QH + 64 * LQ;
    LAS bf16* VBt = KH + 64 * LQ;
    LAS bf16* KBt = VBt + 128 * LT;
    LAS float* At = (LAS float*)(KBt + 128 * LT);
    LAS float* Tm = At + 64 * LA;
    LAS float* Xm = Tm + 64 * LA;
    LAS float* Xa = Xm + 32 * 33;
    LAS bf16* Tb = (LAS bf16*)(Xa + 2 * 16 * 17);
    LAS float* ssq = (LAS float*)(Tb + 64 * LT);
    LAS float* gcs = ssq + 128;
    LAS float* EG = gcs + 64;
    LAS float* EKD = EG + 64;
    LAS float* BEG = EKD + 64;
    LAS float* BT = BEG + 64;
    const bf16* proj = WSP(bf16, O_PROJ); const float* ab = WSP(float, O_AB); const float* convw = a.in[2];
    for (int uid = c.bid; uid < NUNIT; uid += c.G) {
        const int n = uid % NCH, bh = uid / NCH, h = bh % DNH, b = bh / DNH;
        const size_t tok0 = (size_t)b * SEQ + n * CHUNK;
        unsigned char* blk = c.ws + O_DU + (size_t)uid * DU_BYTES;
        int tid = c.tid, lane = c.lane; asm volatile("" : "+v"(tid), "+v"(lane));
        const int wave = c.wave, r = lane & 31, hh = lane >> 5;
        __syncthreads();
        const int quad = tid % 96, tb = tid / 96, mat = quad >> 5, cc = (quad & 31) * 4;
        f32x4 raw[16];
        if (tid < 384) {
            const int col = mat * 1024 + h * 128 + cc;
            f32x4 w[4];
#pragma unroll
            for (int j = 0; j < 4; ++j) w[j] = *(const f32x4*)(convw + j * QKVW + col);
            f32x4 hist[3];
#pragma unroll
            for (int j = 0; j < 3; ++j) { const int t = n * CHUNK + tb * 16 - 3 + j; hist[j] = t >= 0 ? ld_bf16x4(proj + ((size_t)b * SEQ + t) * 4096 + col) : (f32x4){0.f, 0.f, 0.f, 0.f}; }
#pragma unroll
            for (int t = 0; t < 16; ++t) {
                const f32x4 x = ld_bf16x4(proj + (tok0 + tb * 16 + t) * 4096 + col);
                const f32x4 y = hist[0] * w[0] + hist[1] * w[1] + hist[2] * w[2] + x * w[3];
                hist[0] = hist[1]; hist[1] = hist[2]; hist[2] = x;
                raw[t] = (f32x4){siluf_(y.x), siluf_(y.y), siluf_(y.z), siluf_(y.w)};
            }
        }
        if (wave == 7) {
            const float av = ab[(tok0 + lane) * 16 + h], bv = ab[(tok0 + lane) * 16 + 8 + h];
            const float xx = av + a.in[4][h]; const float sp = xx > 20.f ? xx : log1pf(__expf(xx));
            float g = -__expf(a.in[3][h]) * sp;
#pragma unroll
            for (int o = 1; o < 64; o <<= 1) { const float t = __shfl_up(g, o); if (lane >= o) g += t; }
            const float gl = __shfl(g, 63), be = sigmoidf_(bv), eg = __expf(g);
            gcs[lane] = g; EG[lane] = eg; EKD[lane] = __expf(gl - g); BEG[lane] = be * eg; BT[lane] = be;
            if (lane == 0) WSP(float, O_EGL)[uid] = __expf(gl);
        }
        __syncthreads();
        if (tid < 384 && mat < 2) {
            LAS float* part = At + (mat * 32 + (quad & 31)) * 64 + tb * 16;
#pragma unroll
            for (int t = 0; t < 16; t += 4) { f32x4 o;
#pragma unroll
                for (int e = 0; e < 4; ++e) { const f32x4 v = raw[t + e]; o[e] = (v.x * v.x + v.y * v.y) + (v.z * v.z + v.w * v.w); }
                *(LAS f32x4*)(part + t) = o; }
        }
        __syncthreads();
        if (tid < 128) { const LAS float* pp = At + (tid >> 6) * 2048 + (tid & 63); float sm = 0.f;
#pragma unroll 8
            for (int q = 0; q < 32; ++q) sm += pp[q * 64];
            ssq[tid] = sm; }
        __syncthreads();
        if (tid < 384) {
            if (mat == 0) {
                bf16* QG = (bf16*)(blk + DU_QG);
#pragma unroll
                for (int t = 0; t < 16; ++t) { const int tk = tb * 16 + t; const float rn = rsqrtf(ssq[tk] + NORM_EPS) * 0.08838834764831845f; const f32x4 q = raw[t] * rn;
                    u32x2 w; w.x = pk2(q.x, q.y); w.y = pk2(q.z, q.w); *(LAS u32x2*)(QH + tk * LQ + cc) = w;
                    const f32x4 qe = q * EG[tk]; u32x2 g2; g2.x = pk2(qe.x, qe.y); g2.y = pk2(qe.z, qe.w); *(u32x2*)(QG + tk * 128 + (cc & ~15) + perm16(cc & 15)) = g2; }
            } else if (mat == 1) {
                float kn[16][4];
#pragma unroll
                for (int t = 0; t < 16; ++t) { const int tk = tb * 16 + t; const float rn = rsqrtf(ssq[64 + tk] + NORM_EPS); const f32x4 k4 = raw[t] * rn;
                    kn[t][0] = k4.x; kn[t][1] = k4.y; kn[t][2] = k4.z; kn[t][3] = k4.w;
                    u32x2 w; w.x = pk2(k4.x, k4.y); w.y = pk2(k4.z, k4.w); *(LAS u32x2*)(KH + tk * LQ + cc) = w; }
                bf16* KDT = (bf16*)(blk + DU_KDT);
#pragma unroll
                for (int i = 0; i < 4; ++i) {
                    u32x4 lo, hi, d0, d1;
#define KB_(t) (kn[t][i] * BEG[tb * 16 + (t)])
#define KD_(t) (kn[t][i] * EKD[tb * 16 + (t)])
                    lo.x = pk2(KB_(0), KB_(1)); lo.y = pk2(KB_(2), KB_(3)); lo.z = pk2(KB_(4), KB_(5)); lo.w = pk2(KB_(6), KB_(7));
                    hi.x = pk2(KB_(8), KB_(9)); hi.y = pk2(KB_(10), KB_(11)); hi.z = pk2(KB_(12), KB_(13)); hi.w = pk2(KB_(14), KB_(15));
                    d0.x = pk2(KD_(0), KD_(1)); d0.y = pk2(KD_(2), KD_(3)); d0.z = pk2(KD_(8), KD_(9)); d0.w = pk2(KD_(10), KD_(11));
                    d1.x = pk2(KD_(4), KD_(5)); d1.y = pk2(KD_(6), KD_(7)); d1.z = pk2(KD_(12), KD_(13)); d1.w = pk2(KD_(14), KD_(15));
#undef KB_
#undef KD_
                    *(LAS u32x4*)(KBt + (cc + i) * LT + tb * 16) = lo; *(LAS u32x4*)(KBt + (cc + i) * LT + tb * 16 + 8) = hi;
                    *(u32x4*)(KDT + (cc + i) * 64 + tb * 16) = d0; *(u32x4*)(KDT + (cc + i) * 64 + tb * 16 + 8) = d1;
                }
            } else {
#pragma unroll
                for (int i = 0; i < 4; ++i) {
                    u32x4 lo, hi;
#define VB_(t) (raw[t][i] * BT[tb * 16 + (t)])
                    lo.x = pk2(VB_(0), VB_(1)); lo.y = pk2(VB_(2), VB_(3)); lo.z = pk2(VB_(4), VB_(5)); lo.w = pk2(VB_(6), VB_(7));
                    hi.x = pk2(VB_(8), VB_(9)); hi.y = pk2(VB_(10), VB_(11)); hi.z = pk2(VB_(12), VB_(13)); hi.w = pk2(VB_(14), VB_(15));
#undef VB_
                    *(LAS u32x4*)(VBt + (cc + i) * LT + tb * 16) = lo; *(LAS u32x4*)(VBt + (cc + i) * LT + tb * 16 + 8) = hi;
                }
            }
        }
        __syncthreads();
        if (wave < 6) {
            const int tix = wave % 3, I = tix ? 1 : 0, J = (tix == 2) ? 1 : 0;
            f32x16 acc;
#pragma unroll
            for (int j = 0; j < 16; ++j) acc[j] = 0.f;
            if (wave < 3) {
#pragma unroll
                for (int s = 0; s < 8; ++s) { const bf16x8_t fa = *(const LAS bf16x8_t*)(KH + (32 * I + r) * LQ + 16 * s + 8 * hh), fb = *(const LAS bf16x8_t*)(KH + (32 * J + r) * LQ + 16 * s + 8 * hh);
                    acc = __builtin_amdgcn_mfma_f32_32x32x16_bf16(fa, fb, acc, 0, 0, 0); }
                const int j = 32 * J + r; const float gj = gcs[j];
#pragma unroll
                for (int qd = 0; qd < 4; ++qd) { f32x4 o;
#pragma unroll
                    for (int e = 0; e < 4; ++e) { const int i = 32 * I + 8 * qd + 4 * hh + e; o[e] = (i > j) ? BT[i] * acc[4 * qd + e] * __expf(gcs[i] - gj) : 0.f; }
                    *(LAS f32x4*)(At + j * LA + 32 * I + 8 * qd + 4 * hh) = o; }
            } else {
#pragma unroll
                for (int s = 0; s < 8; ++s) { const bf16x8_t fa = *(const LAS bf16x8_t*)(KH + (32 * J + r) * LQ + 16 * s + 8 * hh), fb = *(const LAS bf16x8_t*)(QH + (32 * I + r) * LQ + 16 * s + 8 * hh);
                    acc = __builtin_amdgcn_mfma_f32_32x32x16_bf16(fa, fb, acc, 0, 0, 0); }
                const int i = 32 * I + r; const float gi = gcs[i]; bf16* P = (bf16*)(blk + DU_P) + i * 64;
#pragma unroll
                for (int qd = 0; qd < 4; ++qd) { float o[4]; const int j0 = 32 * J + 8 * qd + 4 * hh;
#pragma unroll
                    for (int e = 0; e < 4; ++e) { const int j = j0 + e; o[e] = (j <= i) ? acc[4 * qd + e] * __expf(gi - gcs[j]) : 0.f; }
                    u32x2 w; w.x = pk2(o[0], o[1]); w.y = pk2(o[2], o[3]); *(u32x2*)(P + (j0 & ~15) + perm16(j0 & 15)) = w; }
            }
        } else {
            const int t2 = tid - 384;
            for (int i = t2; i < 512; i += 128) { const int B = i >> 8, rr = (i >> 4) & 15, c2 = i & 15; Tm[(32 * B + rr) * LA + 32 * B + 16 + c2] = 0.f; }
            for (int i = t2; i < 1024; i += 128) Tm[(i >> 5) * LA + 32 + (i & 31)] = 0.f;
        }
        __syncthreads();
        if (wave == 0) {
            const int o0 = (lane >> 4) * 16, ii = lane & 15; float T[16];
#pragma unroll
            for (int j = 15; j >= 0; --j) { float sacc = (ii == j) ? 1.f : 0.f;
#pragma unroll
                for (int k = j + 1; k < 16; ++k) sacc -= T[k] * At[(o0 + j) * LA + o0 + k];
                T[j] = sacc; }
#pragma unroll
            for (int j = 0; j < 16; j += 4) *(LAS f32x4*)(Tm + lane * LA + o0 + j) = (f32x4){T[j], T[j + 1], T[j + 2], T[j + 3]};
        }
        __syncthreads();
        {
            const int B = tid >> 8, rr = (tid >> 4) & 15, c2 = tid & 15, o = 32 * B; float sm = 0.f;
#pragma unroll
            for (int k = 0; k < 16; ++k) sm += At[(o + k) * LA + o + 16 + rr] * Tm[(o + k) * LA + o + c2];
            Xa[(B * 16 + rr) * 17 + c2] = sm;
            __syncthreads();
            float s2 = 0.f;
#pragma unroll
            for (int k = 0; k < 16; ++k) s2 += Tm[(o + 16 + rr) * LA + o + 16 + k] * Xa[(B * 16 + k) * 17 + c2];
            Tm[(o + 16 + rr) * LA + o + c2] = -s2;
        }
        __syncthreads();
        for (int i = tid; i < 1024; i += 512) { const int rr = i >> 5, c2 = i & 31; float sm = 0.f;
#pragma unroll 8
            for (int k = 0; k < 32; ++k) sm += At[k * LA + 32 + rr] * Tm[k * LA + c2];
            Xm[rr * 33 + c2] = sm; }
        __syncthreads();
        for (int i = tid; i < 1024; i += 512) { const int rr = i >> 5, c2 = i & 31; float sm = 0.f;
#pragma unroll 8
            for (int k = 0; k < 32; ++k) sm += Tm[(32 + rr) * LA + 32 + k] * Xm[k * 33 + c2];
            Tm[(32 + rr) * LA + c2] = -sm; }
        __syncthreads();
        for (int i = tid; i < 1024; i += 512) { const int rr = i >> 4, c4 = (i & 15) * 4; const f32x4 t = *(const LAS f32x4*)(Tm + rr * LA + c4);
            u32x2 w; w.x = pk2(t.x, t.y); w.y = pk2(t.z, t.w); *(LAS u32x2*)(Tb + rr * LT + c4) = w; }
        __syncthreads();
        if (wave < 4) {
            const int ct = wave;
#pragma unroll
            for (int rt = 0; rt < 2; ++rt) { f32x16 acc;
#pragma unroll
                for (int j = 0; j < 16; ++j) acc[j] = 0.f;
#pragma unroll
                for (int jt = 0; jt <= rt; ++jt)
#pragma unroll
                    for (int s2 = 0; s2 < 2; ++s2) { const int ko = 32 * jt + 16 * s2 + 8 * hh; const bf16x8_t fa = *(const LAS bf16x8_t*)(Tb + (32 * rt + r) * LT + ko), fb = *(const LAS bf16x8_t*)(VBt + (32 * ct + r) * LT + ko);
                        acc = __builtin_amdgcn_mfma_f32_32x32x16_bf16(fa, fb, acc, 0, 0, 0); }
#pragma unroll
                for (int hf = 0; hf < 2; ++hf) *(bf16x8_t*)(blk + DU_U + ((((ct * 2 + rt) * 2 + hf) * 64 + lane) << 4)) = pack8(acc, hf);
            }
        } else {
            const int dt = wave - 4; bf16* NW = (bf16*)(blk + DU_NW);
#pragma unroll
            for (int it = 0; it < 2; ++it) { f32x16 acc;
#pragma unroll
                for (int j = 0; j < 16; ++j) acc[j] = 0.f;
#pragma unroll
                for (int jt = 0; jt <= it; ++jt)
#pragma unroll
                    for (int s2 = 0; s2 < 2; ++s2) { const int ko = 32 * jt + 16 * s2 + 8 * hh; const bf16x8_t fa = *(const LAS bf16x8_t*)(KBt + (32 * dt + r) * LT + ko), fb = *(const LAS bf16x8_t*)(Tb + (32 * it + r) * LT + ko);
                        acc = __builtin_amdgcn_mfma_f32_32x32x16_bf16(fa, fb, acc, 0, 0, 0); }
                const int i = 32 * it + r;
#pragma unroll
                for (int qd = 0; qd < 4; ++qd) { const int d0 = 32 * dt + 8 * qd + 4 * hh; u32x2 w; w.x = pk2(-acc[4 * qd], -acc[4 * qd + 1]); w.y = pk2(-acc[4 * qd + 2], -acc[4 * qd + 3]);
                    *(u32x2*)(NW + i * 128 + (d0 & ~15) + perm16(d0 & 15)) = w; }
            }
        }
    }
}
__device__ __forceinline__ bf16x8_t pack8(const f32x16& x, int s) {
    u32x4 w;
    if (s == 0) { w.x = pg8::cvt_pk_bf16(x[0], x[1]); w.y = pg8::cvt_pk_bf16(x[2], x[3]); w.z = pg8::cvt_pk_bf16(x[4], x[5]); w.w = pg8::cvt_pk_bf16(x[6], x[7]); }
    else { w.x = pg8::cvt_pk_bf16(x[8], x[9]); w.y = pg8::cvt_pk_bf16(x[10], x[11]); w.z = pg8::cvt_pk_bf16(x[12], x[13]); w.w = pg8::cvt_pk_bf16(x[14], x[15]); }
    return __builtin_bit_cast(bf16x8_t, w);
}
__device__ __forceinline__ void d2_issue(const Ctx& c, const unsigned char* blk, LAS unsigned char* buf) {
#pragma unroll
    for (int k = 0; k < 9; ++k) {
        const int q = c.wave + 8 * k;
        const unsigned char* src;
        if (q < 32) { const int row = 4 * (q & 15) + (c.lane >> 4), slot = c.lane & 15, cp = slot ^ (row & 15); src = blk + (q >> 4) * 16384 + row * 256 + cp * 16; }
        else if (q < 56) { const int row = 8 * ((q - 32) & 15) + (c.lane >> 3), slot = c.lane & 7, cp = slot ^ (row & 7); src = blk + 32768 + ((q - 32) >> 4) * 16384 + row * 128 + cp * 16; }
        else src = blk + q * 1024 + c.lane * 16;
        __builtin_amdgcn_global_load_lds((const unsigned*)src, (LAS unsigned*)(buf + q * 1024), 16, 0, 0);
    }
}
__device__ __forceinline__ void ph_delta_d2(const Ctx& c) {
    constexpr int STG = 73728;
    if (c.bid >= NB * DNH) return;
    const int bh = c.bid, h = bh % DNH, b = bh / DNH, sl = c.wave, r = c.lane & 31, hh = c.lane >> 5;
    const unsigned char* blk0 = c.ws + O_DU + (size_t)bh * NCH * DU_BYTES;
    const float* egl = WSP(float, O_EGL) + bh * NCH;
    bf16* O = WSP(bf16, O_O);
    f32x16 S[4];
#pragma unroll
    for (int i = 0; i < 4; ++i)
#pragma unroll
        for (int j = 0; j < 16; ++j) S[i][j] = 0.f;
    d2_issue(c, blk0, c.lds);
    for (int n = 0; n < NCH; ++n) {
        LAS unsigned char* buf = c.lds + (n & 1) * STG;
        d2_issue(c, blk0 + (size_t)(n + 1 < NCH ? n + 1 : n) * DU_BYTES, c.lds + ((n + 1) & 1) * STG);
        asm volatile("s_waitcnt vmcnt(9)" ::: "memory");
        __builtin_amdgcn_s_barrier();
        asm volatile("" ::: "memory");
        if (sl < 4) {
            f32x16 av[2], ao[2];
#pragma unroll
            for (int rt = 0; rt < 2; ++rt)
#pragma unroll
                for (int hf = 0; hf < 2; ++hf) { const u32x4 t = *(const LAS u32x4*)(buf + DU_U + ((((sl * 2 + rt) * 2 + hf) * 64 + c.lane) << 4));
                    av[rt][8 * hf + 0] = bf2f(t.x & 0xffffu); av[rt][8 * hf + 1] = bf2f(t.x >> 16); av[rt][8 * hf + 2] = bf2f(t.y & 0xffffu); av[rt][8 * hf + 3] = bf2f(t.y >> 16);
                    av[rt][8 * hf + 4] = bf2f(t.z & 0xffffu); av[rt][8 * hf + 5] = bf2f(t.z >> 16); av[rt][8 * hf + 6] = bf2f(t.w & 0xffffu); av[rt][8 * hf + 7] = bf2f(t.w >> 16); }
#pragma unroll
            for (int j = 0; j < 16; ++j) { ao[0][j] = 0.f; ao[1][j] = 0.f; }
            const float eg = egl[n];
#pragma unroll
            for (int db = 0; db < 4; ++db) {
                bf16x8_t sb[2]; sb[0] = pack8(S[db], 0); sb[1] = pack8(S[db], 1);
#pragma unroll
                for (int rt = 0; rt < 2; ++rt)
#pragma unroll
                    for (int s = 0; s < 2; ++s) { const int row = 32 * rt + r, cp = 4 * db + 2 * s + hh; const int off = row * 256 + ((cp ^ (row & 15)) << 4);
                        const bf16x8_t aw = *(const LAS bf16x8_t*)(buf + off), aq = *(const LAS bf16x8_t*)(buf + 16384 + off);
                        av[rt] = __builtin_amdgcn_mfma_f32_32x32x16_bf16(aw, sb[s], av[rt], 0, 0, 0);
                        ao[rt] = __builtin_amdgcn_mfma_f32_32x32x16_bf16(aq, sb[s], ao[rt], 0, 0, 0); }
                asm volatile("" ::: "memory");
            }
            bf16x8_t vb[2][2];
#pragma unroll
            for (int jt = 0; jt < 2; ++jt) { vb[jt][0] = pack8(av[jt], 0); vb[jt][1] = pack8(av[jt], 1); }
#pragma unroll
            for (int rt = 0; rt < 2; ++rt)
#pragma unroll
                for (int jt = 0; jt <= rt; ++jt)
#pragma unroll
                    for (int s = 0; s < 2; ++s) { const int row = 32 * rt + r, cp = 4 * jt + 2 * s + hh; const bf16x8_t ap = *(const LAS bf16x8_t*)(buf + 49152 + row * 128 + ((cp ^ (row & 7)) << 4));
                        ao[rt] = __builtin_amdgcn_mfma_f32_32x32x16_bf16(ap, vb[jt][s], ao[rt], 0, 0, 0); }
            bf16* orow = O + ((size_t)b * SEQ + n * CHUNK) * D + h * 128 + sl * 32 + r;
#pragma unroll
            for (int rt = 0; rt < 2; ++rt)
#pragma unroll
                for (int j = 0; j < 16; ++j) { const int tkn = 32 * rt + (j & 3) + 8 * (j >> 2) + 4 * hh; orow[(size_t)tkn * D] = (bf16)f2bf(ao[rt][j]); }
#pragma unroll
            for (int db = 0; db < 4; ++db) {
#pragma unroll
                for (int j = 0; j < 16; ++j) S[db][j] *= eg;
#pragma unroll
                for (int jt = 0; jt < 2; ++jt)
#pragma unroll
                    for (int s = 0; s < 2; ++s) { const int row = 32 * db + r, cp = 4 * jt + 2 * s + hh; const bf16x8_t ak = *(const LAS bf16x8_t*)(buf + 32768 + row * 128 + ((cp ^ (row & 7)) << 4));
                        S[db] = __builtin_amdgcn_mfma_f32_32x32x16_bf16(ak, vb[jt][s], S[db], 0, 0, 0); }
                asm volatile("" ::: "memory");
            }
        }
        asm volatile("s_waitcnt lgkmcnt(0)" ::: "memory");
        __builtin_amdgcn_s_barrier();
        asm volatile("" ::: "memory");
    }
    asm volatile("s_waitcnt vmcnt(0)" ::: "memory");
    __builtin_amdgcn_s_barrier();
}

__device__ __forceinline__ void ph_gatednorm(const Ctx& c, const Args& a) {
    const bf16* O = WSP(bf16, O_O); const bf16* proj = WSP(bf16, O_PROJ); bf16* og = WSP(bf16, O_OG);
    const float* gn = a.in[5];
    for (int row = c.bid * 8 + c.wave; row < NT; row += c.G * 8) {
#pragma unroll
        for (int j = 0; j < 4; ++j) {
            const int col = 4 * c.lane + 256 * j;
            const f32x4 o = ld_bf16x4(O + (size_t)row * D + col), z = ld_bf16x4(proj + (size_t)row * 4096 + 3072 + col);
            float s = o.x * o.x + o.y * o.y + o.z * o.z + o.w * o.w;
#pragma unroll
            for (int m = 1; m < 32; m <<= 1) s += __shfl_xor(s, m);
            const float rs = rsqrtf(s * (1.f / 128.f) + NORM_EPS);
            const f32x4 g = *(const f32x4*)(gn + (col & 127));
            u32x2 w; w.x = pk2(o.x * rs * g.x * siluf_(z.x), o.y * rs * g.y * siluf_(z.y)); w.y = pk2(o.z * rs * g.z * siluf_(z.z), o.w * rs * g.w * siluf_(z.w));
            *(u32x2*)(og + (size_t)row * D + col) = w;
        }
    }
}

__device__ __forceinline__ void ph_proj1024(const Ctx& c, const bf16* A, const float* W, int ldw, bf16* C, float scale) {
    for (int u = c.bid; u < (NT / 128) * 8; u += c.G) {
        const int mb = u >> 3, nb = u & 7;
        gg_tile(c, D, ALin{A + (size_t)mb * 128 * D, D}, BPlain{W + nb * 128, ldw}, EBf16{C + (size_t)mb * 128 * D + nb * 128, D, scale});
    }
}

__device__ __forceinline__ void ln_finish(const Ctx& c, f32x4 (&v)[4], const float* g, const float* b, float* outf, bf16* outb, size_t row) {
    float s = 0.f;
#pragma unroll
    for (int j = 0; j < 4; ++j) s += (v[j].x + v[j].y) + (v[j].z + v[j].w);
    const float mean = wave_sum(s) * (1.f / D); float s2 = 0.f;
#pragma unroll
    for (int j = 0; j < 4; ++j) { v[j] = v[j] - mean; s2 += (v[j].x * v[j].x + v[j].y * v[j].y) + (v[j].z * v[j].z + v[j].w * v[j].w); }
    const float rstd = rsqrtf(wave_sum(s2) * (1.f / D) + LN_EPS);
#pragma unroll
    for (int j = 0; j < 4; ++j) {
        const int col = 4 * c.lane + 256 * j;
        const f32x4 gg = *(const f32x4*)(g + col), bb = *(const f32x4*)(b + col);
        const f32x4 o = v[j] * rstd * gg + bb;
        *(f32x4*)(outf + row * D + col) = o;
        if (outb) { u32x2 w; w.x = pk2(o.x, o.y); w.y = pk2(o.z, o.w); *(u32x2*)(outb + row * D + col) = w; }
    }
}
__device__ __forceinline__ void ph_ln_mix(const Ctx& c, const float* xin, const bf16* mix, const float* g, const float* b, float* outf, bf16* outb) {
    for (int row = c.bid * 8 + c.wave; row < NT; row += c.G * 8) {
        f32x4 v[4];
#pragma unroll
        for (int j = 0; j < 4; ++j) { const int col = 4 * c.lane + 256 * j; v[j] = *(const f32x4*)(xin + (size_t)row * D + col) * ALPHA + ld_bf16x4(mix + (size_t)row * D + col); }
        ln_finish(c, v, g, b, outf, outb, (size_t)row);
    }
}

__device__ __forceinline__ void ph_router_shared(const Ctx& c, const Args& a, int layer) {
    const bf16* xb = WSP(bf16, O_XB); float* logits = WSP(float, O_LOG); bf16* H = WSP(bf16, O_H);
    const float* wr = a.in[11] + (size_t)layer * D * NE; const float* wsg = a.in[15] + (size_t)layer * D * 512;
    for (int u = c.bid; u < (NT / 128) * 2; u += c.G) {
        const int mb = u >> 1, nb = u & 1;
        gg_tile(c, D, ALin{xb + (size_t)mb * 128 * D, D}, BPlain{wr + nb * 128, NE}, EF32{logits + (size_t)mb * 128 * NE + nb * 128, NE});
    }
    for (int u = c.bid; u < (NT / 128) * 4; u += c.G) {
        const int mb = u >> 2, nb = u & 3;
        gg_tile(c, D, ALin{xb + (size_t)mb * 128 * D, D}, BGateUp{wsg + nb * 64, 512, 256}, ESwiglu{H + (size_t)(SH0 + mb * 128) * DE + nb * 64, DE});
    }
}

__device__ __forceinline__ void ph_route(const Ctx& c, const Args& a, int layer) {
    LAS int* hist = (LAS int*)c.lds;
    LAS int* base = hist + 256;
    LAS int* rec_e = base + 256;
    LAS int* rec_r = rec_e + 1024;
    const float* logits = WSP(float, O_LOG); const float* rbias = a.in[12] + layer * NE;
    int* eidx = WSP(int, O_EIDX); int* slot = WSP(int, O_SLOT); float* gate = WSP(float, O_GATE); int* list = WSP(int, O_LIST);
    unsigned* counts = WSP(unsigned, O_CTL) + CW_CNT + 256 * layer;
    const float NINF = -__builtin_inff();
    for (int blk = c.bid; blk < NT / 128; blk += c.G) {
        if (c.tid < 256) hist[c.tid] = 0;
        __syncthreads();
        for (int i = 0; i < 16; ++i) {
            const int tl = c.wave * 16 + i, tok = blk * 128 + tl;
            const f32x4 lg = *(const f32x4*)(logits + (size_t)tok * NE + 4 * c.lane);
            const f32x4 bs = *(const f32x4*)(rbias + 4 * c.lane);
            float sc[4], sel[4];
#pragma unroll
            for (int j = 0; j < 4; ++j) { sc[j] = sigmoidf_(lg[j]); sel[j] = sc[j] + bs[j]; }
            float m1 = fmaxf(sel[0], sel[1]), m2 = fminf(sel[0], sel[1]);
#pragma unroll
            for (int j = 2; j < 4; ++j) { const float v = sel[j]; m2 = fmaxf(m2, fminf(m1, v)); m1 = fmaxf(m1, v); }
#pragma unroll
            for (int o = 1; o < 8; o <<= 1) { const float o1 = __shfl_xor(m1, o), o2 = __shfl_xor(m2, o); m2 = fmaxf(fminf(m1, o1), fmaxf(m2, o2)); m1 = fmaxf(m1, o1); }
            const float gs = m1 + m2; const int myg = c.lane >> 3; int rank = 0;
#pragma unroll
            for (int j = 0; j < 8; ++j) { const float s = __shfl(gs, 8 * j); rank += (s > gs || (s == gs && j < myg)) ? 1 : 0; }
            if (rank >= 4) { sel[0] = NINF; sel[1] = NINF; sel[2] = NINF; sel[3] = NINF; }
            float wsum = 0.f, myw = 0.f; int mye = 0;
#pragma unroll
            for (int r = 0; r < 8; ++r) {
                float bv = sel[0]; int bi = 4 * c.lane;
#pragma unroll
                for (int j = 1; j < 4; ++j) if (sel[j] > bv) { bv = sel[j]; bi = 4 * c.lane + j; }
#pragma unroll
                for (int o = 32; o >= 1; o >>= 1) { const float ov = __shfl_xor(bv, o); const int oi = __shfl_xor(bi, o); if (ov > bv || (ov == bv && oi < bi)) { bv = ov; bi = oi; } }
                const int own = bi >> 2, jj = bi & 3;
                float mine = sc[0]; mine = (jj == 1) ? sc[1] : mine; mine = (jj == 2) ? sc[2] : mine; mine = (jj == 3) ? sc[3] : mine;
                const float w = __shfl(mine, own);
                if (c.lane == own) { sel[0] = (jj == 0) ? NINF : sel[0]; sel[1] = (jj == 1) ? NINF : sel[1]; sel[2] = (jj == 2) ? NINF : sel[2]; sel[3] = (jj == 3) ? NINF : sel[3]; }
                wsum += w; if (c.lane == r) { myw = w; mye = bi; }
            }
            if (c.lane < 8) {
                const float gt = myw / wsum * ROUTED_SCALE;
                eidx[(size_t)tok * 8 + c.lane] = mye; gate[(size_t)tok * 8 + c.lane] = gt;
                rec_e[tl * 8 + c.lane] = mye; rec_r[tl * 8 + c.lane] = __hip_atomic_fetch_add(&hist[mye], 1, __ATOMIC_RELAXED, __HIP_MEMORY_SCOPE_WORKGROUP);
            }
        }
        __syncthreads();
        if (c.tid < 256) { const int n = hist[c.tid]; base[c.tid] = n ? (int)atomicAdd(&counts[c.tid], (unsigned)n) : 0; }
        __syncthreads();
        for (int i = c.tid; i < 1024; i += 512) {
            const int e = rec_e[i], s = base[e] + rec_r[i], tok = blk * 128 + (i >> 3);
            slot[(size_t)tok * 8 + (i & 7)] = s; list[(size_t)e * NT + s] = tok;
        }
        __syncthreads();
    }
}

__device__ __forceinline__ void moe_tables(const Ctx& c, int layer, LAS int* ts, LAS int* cnt) {
    const unsigned* counts = WSP(unsigned, O_CTL) + CW_CNT + 256 * layer;
    if (c.tid < 256) cnt[c.tid] = (int)__hip_atomic_load(counts + c.tid, __ATOMIC_RELAXED, __HIP_MEMORY_SCOPE_AGENT);
    __syncthreads();
    if (c.tid == 0) { int s = 0; for (int e = 0; e < 256; ++e) { ts[e] = s; s += (cnt[e] + 255) >> 8; } ts[256] = s; }
    __syncthreads();
}
__device__ __forceinline__ int find_expert(const LAS int* ts, int mt) { int lo = 0, hi = 255; while (lo < hi) { const int mid = (lo + hi + 1) >> 1; if (ts[mid] <= mt) lo = mid; else hi = mid - 1; } return lo; }

__device__ __forceinline__ void ph_moe_gu(const Ctx& c, const Args& a, int layer) {
    LAS int* ts = (LAS int*)(c.lds + 20480); LAS int* cnt = ts + 260; LAS int* rows = cnt + 256;
    moe_tables(c, layer, ts, cnt);
    const bf16* xb = WSP(bf16, O_XB); bf16* H = WSP(bf16, O_H); const int* list = WSP(int, O_LIST);
    const int ntile = ts[256];
    for (int u = c.bid; u < ntile * 8; u += c.G) {
        const int mt = u >> 3, sub = u & 7, rh = sub >> 2, cb = sub & 3;
        int e = find_expert(ts, mt);
        while (ts[e + 1] <= mt) ++e;
        __syncthreads();
        if (c.tid < 128) { const int s = (mt - ts[e]) * 256 + rh * 128 + c.tid; rows[c.tid] = s < cnt[e] ? list[(size_t)e * NT + s] : 0; }
        __syncthreads();
        const float* W = a.in[13] + ((size_t)layer * NE + e) * D * 512;
        gg_tile(c, D, AGather{xb, D, rows}, BGateUp{W + cb * 64, 512, 256}, ESwiglu{H + (size_t)(mt * 256 + rh * 128) * DE + cb * 64, DE});
    }
}
__device__ __forceinline__ void ph_moe_down(const Ctx& c, const Args& a, int layer) {
    LAS int* ts = (LAS int*)(c.lds + 20480); LAS int* cnt = ts + 260;
    moe_tables(c, layer, ts, cnt);
    const bf16* H = WSP(bf16, O_H); bf16* Y = WSP(bf16, O_Y);
    const int ntile = ts[256];
    for (int u = c.bid; u < (ntile + NT / 256) * 16; u += c.G) {
        const int mt = u >> 4, sub = u & 15, rh = sub >> 3, nb = sub & 7;
        const float* W; size_t row0;
        if (mt < ntile) { int e = find_expert(ts, mt); while (ts[e + 1] <= mt) ++e; W = a.in[14] + ((size_t)layer * NE + e) * DE * D; row0 = (size_t)mt * 256 + rh * 128; }
        else { W = a.in[16] + (size_t)layer * DE * D; row0 = (size_t)SH0 + (size_t)(mt - ntile) * 256 + rh * 128; }
        gg_tile(c, DE, ALin{H + row0 * DE, DE}, BPlain{W + nb * 128, D}, EBf16{Y + row0 * D + nb * 128, D, 1.f});
    }
}
__device__ __forceinline__ void ph_combine_ln(const Ctx& c, const Args& a, int layer, const float* xin, float* outf, bf16* outb) {
    LAS int* ts = (LAS int*)(c.lds + 20480); LAS int* cnt = ts + 260;
    moe_tables(c, layer, ts, cnt);
    const bf16* Y = WSP(bf16, O_Y); const int* eidx = WSP(int, O_EIDX); const int* slot = WSP(int, O_SLOT); const float* gate = WSP(float, O_GATE);
    const float* g = a.in[19] + layer * D; const float* b = a.in[20] + layer * D;
    for (int row = c.bid * 8 + c.wave; row < NT; row += c.G * 8) {
        int me = 0, ms = 0; float mg = 0.f;
        if (c.lane < 8) { me = eidx[(size_t)row * 8 + c.lane]; ms = slot[(size_t)row * 8 + c.lane]; mg = gate[(size_t)row * 8 + c.lane]; }
        const int myrow = (c.lane < 8) ? ts[me] * 256 + ms : 0;
        f32x4 v[4];
#pragma unroll
        for (int j = 0; j < 4; ++j) { const int col = 4 * c.lane + 256 * j; v[j] = *(const f32x4*)(xin + (size_t)row * D + col) * ALPHA + ld_bf16x4(Y + ((size_t)SH0 + row) * D + col); }
#pragma unroll
        for (int k = 0; k < 8; ++k) {
            const int yr = __shfl(myrow, k); const float gk = __shfl(mg, k);
#pragma unroll
            for (int j = 0; j < 4; ++j) { const int col = 4 * c.lane + 256 * j; v[j] += ld_bf16x4(Y + (size_t)yr * D + col) * gk; }
        }
        ln_finish(c, v, g, b, outf, outb, (size_t)row);
    }
}

__device__ __forceinline__ void ph_qkv(const Ctx& c, const Args& a) {
    const bf16* xb = WSP(bf16, O_XB); bf16* Q = WSP(bf16, O_Q); bf16* Kb = WSP(bf16, O_K); bf16* VT = WSP(bf16, O_VT);
    for (int u = c.bid; u < (NT / 128) * 24; u += c.G) {
        const int mb = u / 24, nb = u % 24;
        if (nb < 8) gg_tile(c, D, ALin{xb + (size_t)mb * 128 * D, D}, BPlain{a.in[8] + nb * 128, D}, EBf16{Q + (size_t)mb * 128 * D + nb * 128, D, 0.125f});
        else if (nb < 16) gg_tile(c, D, ALin{xb + (size_t)mb * 128 * D, D}, BPlain{a.in[7] + (nb - 8) * 128, 2048}, EBf16{Kb + (size_t)mb * 128 * D + (nb - 8) * 128, D, 1.f});
        else gg_tile(c, D, ALin{xb + (size_t)mb * 128 * D, D}, BPlain{a.in[7] + 1024 + (nb - 16) * 128, 2048}, EBf16T{VT + (size_t)(nb - 16) * 128 * NT + (size_t)mb * 128, NT});
    }
}
__device__ __forceinline__ void ph_attn_golden(const Ctx& c, const Args& a) {
    const bf16* Q = WSP(bf16, O_Q); const bf16* Kb = WSP(bf16, O_K); const bf16* VT = WSP(bf16, O_VT); bf16* AO = WSP(bf16, O_OG);
    const float* relb = a.in[9];
    for (int u = c.bid * 8 + c.wave; u < NB * NCH * AH; u += c.G * 8) {
        const int h = u % AH, bc = u / AH, ch = bc % NCH, b = bc / NCH;
        const size_t tok = (size_t)b * SEQ + ch * 64 + c.lane;
        float q[64], o[64];
#pragma unroll
        for (int d = 0; d < 64; d += 4) { const f32x4 t = ld_bf16x4(Q + tok * D + h * 64 + d); q[d] = t.x; q[d + 1] = t.y; q[d + 2] = t.z; q[d + 3] = t.w; }
#pragma unroll
        for (int d = 0; d < 64; ++d) o[d] = 0.f;
        float m = -1e30f, l = 0.f;
        const int j0 = (ch < LEFT) ? (LEFT - ch) * 64 : 0;
        for (int j = j0; j < BAND; ++j) {
            const int kpos = ch * 64 - LEFT * 64 + j;
            const bf16* kr = Kb + ((size_t)b * SEQ + kpos) * D + h * 64;
            float s = 0.f;
#pragma unroll
            for (int d = 0; d < 64; d += 4) { const f32x4 t = ld_bf16x4(kr + d); s += q[d] * t.x + q[d + 1] * t.y + q[d + 2] * t.z + q[d + 3] * t.w; }
            int rel = c.lane + LEFT * 64 - j; rel = rel < -63 ? -63 : (rel > 256 ? 256 : rel);
            s += relb[h * RELN + rel + 63];
            const float mn = fmaxf(m, s), corr = __expf(m - mn), p = __expf(s - mn);
            l = l * corr + p; m = mn;
            const bf16* vc = VT + (size_t)(h * 64) * NT + (size_t)b * SEQ + kpos;
#pragma unroll
            for (int d = 0; d < 64; ++d) o[d] = o[d] * corr + p * bf2f(vc[(size_t)d * NT]);
        }
        const float il = 1.f / l;
#pragma unroll
        for (int d = 0; d < 64; d += 4) { u32x2 w; w.x = pk2(o[d] * il, o[d + 1] * il); w.y = pk2(o[d + 2] * il, o[d + 3] * il); *(u32x2*)(AO + tok * D + h * 64 + d) = w; }
    }
}

__device__ __forceinline__ void ph_attn(const Ctx& c, const Args& a) {
    LAS float* rb = (LAS float*)c.lds;
    for (int i = c.tid; i < AH * RELN; i += 512) rb[i] = a.in[9][i];
    __syncthreads();
    const bf16* Q = WSP(bf16, O_Q); const bf16* Kb = WSP(bf16, O_K); const bf16* VT = WSP(bf16, O_VT); bf16* AO = WSP(bf16, O_OG);
    const int r = c.lane & 31, hh = c.lane >> 5;
    for (int wu = c.bid * 8 + c.wave; wu < NB * NCH * AH * 2; wu += c.G * 8) {
        const int qh = wu & 1, h = (wu >> 1) & 15, bc = wu >> 5, ch = bc % NCH, b = bc / NCH;
        const size_t tokq = (size_t)b * SEQ + ch * 64 + qh * 32 + r;
        bf16x8_t qf[4];
#pragma unroll
        for (int s = 0; s < 4; ++s) qf[s] = *(const bf16x8_t*)(Q + tokq * D + h * 64 + 16 * s + 8 * hh);
        f32x16 oacc[2];
#pragma unroll
        for (int j = 0; j < 16; ++j) { oacc[0][j] = 0.f; oacc[1][j] = 0.f; }
        float m = -1e30f, l = 0.f;
        const LAS float* rbh = rb + h * RELN;
        const float bmax = rbh[RELN - 1];
        const int kt0 = (ch < LEFT) ? 2 * (LEFT - ch) : 0;
        for (int kt = kt0; kt < 18; ++kt) {
            const int kpos0 = ch * 64 - LEFT * 64 + 32 * kt;
            const bf16* kr = Kb + ((size_t)b * SEQ + kpos0 + r) * D + h * 64 + 8 * hh;
            f32x16 sa;
#pragma unroll
            for (int j = 0; j < 16; ++j) sa[j] = 0.f;
#pragma unroll
            for (int s = 0; s < 4; ++s) { const bf16x8_t kf = *(const bf16x8_t*)(kr + 16 * s); sa = __builtin_amdgcn_mfma_f32_32x32x16_bf16(kf, qf[s], sa, 0, 0, 0); }
            if (32 * kt <= 225 + 32 * qh) {
#pragma unroll
                for (int j = 0; j < 16; ++j) sa[j] += bmax;
            } else {
                const int rel0 = 32 * qh + r + LEFT * 64 - 32 * kt - 4 * hh + 63;
#pragma unroll
                for (int j = 0; j < 16; ++j) { int idx = rel0 - ((j & 3) + 8 * (j >> 2)); idx = idx > 319 ? 319 : idx; sa[j] += rbh[idx]; }
            }
            float mx = sa[0];
#pragma unroll
            for (int j = 1; j < 16; ++j) mx = fmaxf(mx, sa[j]);
            mx = fmaxf(mx, __shfl_xor(mx, 32));
            const float mn = fmaxf(m, mx), corr = __expf(m - mn);
            float ps = 0.f;
#pragma unroll
            for (int j = 0; j < 16; ++j) { sa[j] = __expf(sa[j] - mn); ps += sa[j]; }
            ps += __shfl_xor(ps, 32);
            l = l * corr + ps; m = mn;
#pragma unroll
            for (int j = 0; j < 16; ++j) { oacc[0][j] *= corr; oacc[1][j] *= corr; }
            bf16x8_t pb[2]; pb[0] = pack8(sa, 0); pb[1] = pack8(sa, 1);
            const bf16* vr = VT + (size_t)(h * 64 + r) * NT + (size_t)b * SEQ + kpos0 + 4 * hh;
#pragma unroll
            for (int dt = 0; dt < 2; ++dt)
#pragma unroll
                for (int s = 0; s < 2; ++s) { const u32x2 v0 = *(const u32x2*)(vr + (size_t)dt * 32 * NT + 16 * s), v1 = *(const u32x2*)(vr + (size_t)dt * 32 * NT + 16 * s + 8);
                    u32x4 vv; vv.x = v0.x; vv.y = v0.y; vv.z = v1.x; vv.w = v1.y;
                    oacc[dt] = __builtin_amdgcn_mfma_f32_32x32x16_bf16(__builtin_bit_cast(bf16x8_t, vv), pb[s], oacc[dt], 0, 0, 0); }
        }
        const float inv = 1.f / l;
#pragma unroll
        for (int dt = 0; dt < 2; ++dt)
#pragma unroll
            for (int qd = 0; qd < 4; ++qd) { u32x2 w; w.x = pg8::cvt_pk_bf16(oacc[dt][4 * qd] * inv, oacc[dt][4 * qd + 1] * inv); w.y = pg8::cvt_pk_bf16(oacc[dt][4 * qd + 2] * inv, oacc[dt][4 * qd + 3] * inv);
                *(u32x2*)(AO + tokq * D + h * 64 + 32 * dt + 8 * qd + 4 * hh) = w; }
    }
}

constexpr int LDS_TAB = pg8::STAGE_BYTES;
__device__ __forceinline__ int vcu_of(const Ctx& c) { return (c.G % 8 == 0) ? (c.bid & 7) * (c.G >> 3) + (c.bid >> 3) : c.bid; }
__device__ __forceinline__ void ph_dense1024(const Ctx& c, const bf16* A, const bf16* Bt, bf16* O) {
    pg8::DenseSched S; S.T.init(NT / 256, 4, c.G, c.bid); S.A = A; S.Bt = Bt; S.K = D; S.O = O; S.ldc = D; S.scale = 1.f;
    pg8::gemm_run(c.tid, c.lds, (const LAS int*)(c.lds + LDS_TAB), D, S, pg8::EpiBf16{});
}
__device__ __forceinline__ void ph_qkv_fast(const Ctx& c) {
    pg8::QkvSched S; S.T1.init(NT / 256, 8, c.G, c.bid); S.T2.init(4, NT / 256, c.G, c.bid); S.G = c.G; S.c = c.bid;
    S.XB = WSP(bf16, O_XB); S.WQK = WSP(bf16, O_WQK); S.WV = WSP(bf16, O_WV); S.Q = WSP(bf16, O_Q); S.Kb = WSP(bf16, O_K); S.VT = WSP(bf16, O_VT);
    pg8::gemm_run(c.tid, c.lds, (const LAS int*)(c.lds + LDS_TAB), D, S, pg8::EpiBf16{});
}
__device__ __forceinline__ void ph_router_shared_fast(const Ctx& c, int layer) {
    pg8::RouterSharedSched S; S.G = c.G; S.c = c.bid; S.XB = WSP(bf16, O_XB); S.WRS = WSP(bf16, O_WRS) + (size_t)layer * 768 * D; S.logits = WSP(float, O_LOG); S.H = WSP(bf16, O_H);
    pg8::gemm_run(c.tid, c.lds, (const LAS int*)(c.lds + LDS_TAB), D, S, pg8::EpiMoe{});
}
__device__ __forceinline__ void ph_moe_gu_fast(const Ctx& c, int layer) {
    LAS int* ts = (LAS int*)(c.lds + LDS_TAB); LAS int* cnt = ts + 260; LAS int* rows = cnt + 256;
    moe_tables(c, layer, ts, cnt);
    const int ntile = ts[256], vc = vcu_of(c); const int* list = WSP(int, O_LIST);
    for (int i = 0; i < 12; ++i) {
        const int L = i * c.G + vc; if (L >= 2 * ntile) break;
        const int mt = L >> 1; const int e = find_expert(ts, mt);
        if (c.tid < 256) { const int sl = (mt - ts[e]) * 256 + c.tid; rows[i * 256 + c.tid] = sl < cnt[e] ? list[(size_t)e * NT + sl] : 0; }
    }
    __syncthreads();
    pg8::MoeGuSched S; S.G = c.G; S.vc = vc; S.ntile = ntile; S.ts = ts; S.XB = WSP(bf16, O_XB); S.WGU = WSP(bf16, O_WGU) + (size_t)layer * NE * 512 * D; S.H = WSP(bf16, O_H);
    pg8::gemm_run(c.tid, c.lds, rows, D, S, pg8::EpiMoe{});
}
__device__ __forceinline__ void ph_moe_down_fast(const Ctx& c, int layer) {
    LAS int* ts = (LAS int*)(c.lds + LDS_TAB); LAS int* cnt = ts + 260;
    moe_tables(c, layer, ts, cnt);
    pg8::MoeDownSched S; S.G = c.G; S.vc = vcu_of(c); S.ntile = ts[256]; S.ts = ts; S.H = WSP(bf16, O_H); S.WD = WSP(bf16, O_WD) + (size_t)layer * NE * D * DE; S.WSD = WSP(bf16, O_WSD) + (size_t)layer * D * DE; S.Y = WSP(bf16, O_Y);
    int Kd = DE; asm volatile("" : "+s"(Kd));
    pg8::gemm_run(c.tid, c.lds, (const LAS int*)(c.lds + LDS_TAB), Kd, S, pg8::EpiBf16{});
}

__device__ __forceinline__ void ph_phase0(const Ctx& c, const Args& a) {
    ph_prologue(c, a); __syncthreads(); const int gw = c.bid * 8 + c.wave, NGW = c.G * 8;
    cvt_small_weights(c, a, gw, NGW); cvt_expert_weights(c, a, gw, NGW, 0); cvt_expert_weights(c, a, gw, NGW, 1);
}
__device__ __forceinline__ bool fresh(Ctx& c) { int t = threadIdx.x; asm volatile("" : "+v"(t)); c.tid = t; c.lane = t & 63; c.wave = __builtin_amdgcn_readfirstlane(t >> 6); return true; }
__global__ void __launch_bounds__(512, 2) fwd(Args args) {
    extern __shared__ __attribute__((aligned(16))) unsigned char lds_raw[];
    Ctx c; c.lds = (LAS unsigned char*)lds_raw; c.ws = args.ws;
    c.tid = threadIdx.x; c.lane = c.tid & 63; c.wave = __builtin_amdgcn_readfirstlane(c.tid >> 6); c.bid = blockIdx.x; c.G = gridDim.x;
    volatile LAS unsigned* xbw = (volatile LAS unsigned*)(c.lds + LDS_BYTES - 16);
    if (c.tid == 0) { xbw[0] = 0u; xbw[1] = 0u; }
    __syncthreads();
    XcdBarrier bar; bar.bar = (unsigned*)(args.ws + O_CTL) + CW_BAR; bar.x = 0; bar.st = xbw;
#if !MK_SPLIT
    bar = xcd_barrier_post((unsigned*)(args.ws + O_CTL) + CW_BAR, xbw);
#endif
    const int lo = args.ph_lo, hi = args.ph_hi;
#ifndef PH_MASK
#define PH_MASK 0x1FFFFFu
#endif
#define IN(k) (((PH_MASK >> (k)) & 1u) && lo <= (k) && (k) < hi && fresh(c))
#define RUN(k, call) do { if (IN(k)) { call; if ((DUP_MASK >> (k)) & 1u) { xcd_barrier(bar); call; } } } while (0)
#if MK_SPLIT
#define SEAM(k) do { } while (0)
#else
#define SEAM(k) do { if (lo <= (k) && (k) + 1 < hi) xcd_barrier(bar); } while (0)
#endif
    float* XFA = (float*)(args.ws + O_XFA); float* XFB = (float*)(args.ws + O_XFB); bf16* XBp = (bf16*)(args.ws + O_XB);
    bf16* OG = (bf16*)(args.ws + O_OG); bf16* MIX = (bf16*)(args.ws + O_MIX);
    RUN(0, ph_phase0(c, args));
    SEAM(0);
    RUN(1, ph_inproj(c, args));
    SEAM(1);
#if DELTA_GOLDEN
    RUN(2, ph_delta_golden(c, args));
    SEAM(2);
    SEAM(3);
#else
    RUN(2, ph_delta_d1_fast(c, args));
    SEAM(2);
    RUN(3, ph_delta_d2(c));
    SEAM(3);
#endif
    RUN(4, ph_gatednorm(c, args));
    SEAM(4);
    RUN(5, ph_dense1024(c, OG, (const bf16*)(args.ws + O_WOA), MIX));
    SEAM(5);
    RUN(6, ph_ln_mix(c, args.in[0], MIX, args.in[17], args.in[18], XFA, XBp));
    SEAM(6);
    RUN(7, ph_router_shared_fast(c, 0));
    SEAM(7);
    RUN(8, ph_route(c, args, 0));
    SEAM(8);
    RUN(9, ph_moe_gu_fast(c, 0));
    SEAM(9);
    RUN(10, ph_moe_down_fast(c, 0));
    SEAM(10);
    RUN(11, ph_combine_ln(c, args, 0, XFA, XFB, XBp));
    SEAM(11);
    RUN(12, ph_qkv_fast(c));
    SEAM(12);
    RUN(13, ph_attn(c, args));
    SEAM(13);
    RUN(14, ph_dense1024(c, OG, (const bf16*)(args.ws + O_WOB), MIX));
    SEAM(14);
    RUN(15, ph_ln_mix(c, XFB, MIX, args.in[17] + D, args.in[18] + D, XFA, XBp));
    SEAM(15);
    RUN(16, ph_router_shared_fast(c, 1));
    SEAM(16);
    RUN(17, ph_route(c, args, 1));
    SEAM(17);
    RUN(18, ph_moe_gu_fast(c, 1));
    SEAM(18);
    RUN(19, ph_moe_down_fast(c, 1));
    SEAM(19);
    RUN(20, ph_combine_ln(c, args, 1, XFA, args.out, nullptr));
#undef IN
#undef SEAM
#undef RUN
}

extern "C" void kernel_launch(void* const* d_in, const int* in_sizes, int n_in, void* d_out, int out_size, void* d_ws, size_t ws_size, hipStream_t stream) {
    static int grid = 0;
    if (grid == 0) {
        if (n_in != 21 || out_size != NT * D || ws_size < O_END) { fprintf(stderr, "kernel_launch: unexpected problem: n_in %d out %d ws %zu (need %zu)\n", n_in, out_size, ws_size, (size_t)O_END); grid = -1; return; }
        int dev = 0, cus = 0, per_cu = 0;
        if (hipGetDevice(&dev) != hipSuccess || hipDeviceGetAttribute(&cus, hipDeviceAttributeMultiprocessorCount, dev) != hipSuccess) { grid = -1; return; }
        if (hipFuncSetAttribute((const void*)fwd, hipFuncAttributeMaxDynamicSharedMemorySize, LDS_BYTES) != hipSuccess) { fprintf(stderr, "kernel_launch: hipFuncSetAttribute failed\n"); grid = -1; return; }
        if (hipOccupancyMaxActiveBlocksPerMultiprocessor(&per_cu, (const void*)fwd, 512, LDS_BYTES) != hipSuccess || per_cu < 1) fprintf(stderr, "kernel_launch: occupancy query says %d\n", per_cu);
        (void)hipGetLastError();
        grid = cus;
    }
    if (grid < 0) return;
    (void)hipMemsetAsync((char*)d_ws + O_CTL, 0, CTL_BYTES, stream);
    Args a{};
    for (int i = 0; i < 21; ++i) a.in[i] = (const float*)d_in[i];
    a.out = (float*)d_out; a.ws = (unsigned char*)d_ws;
#if MK_SPLIT
    for (int p = 0; p < NPHASE; ++p) { a.ph_lo = p; a.ph_hi = p + 1; hipLaunchKernelGGL(fwd, dim3(grid), dim3(512), LDS_BYTES, stream, a); }
#else
    a.ph_lo = 0; a.ph_hi = NPHASE; hipLaunchKernelGGL(fwd, dim3(grid), dim3(512), LDS_BYTES, stream, a);
#endif
}
```
